# Optimizing an MI355X kernel written in HIP

```python
import math
import jax, jax.numpy as jnp
from jax import lax
import numpy as np


D_MODEL = 1024
BATCH = 2
SEQ = 16384
DEPTH = 2

HEAD_DIM = 64
A_HEADS = 8
A_KV = 2
B_HEADS = 8
B_KV = 2
C_HEADS = 4
C_KV = 2
C_V_DIM = 2 * HEAD_DIM
WINDOW = 128
BLOCK = 128
GRID_W = 64
ROPE_THETA = 10000.0
NUM_BUCKETS = 32
MAX_DISTANCE = 128
N_BIAS_HEADS = B_HEADS + C_HEADS
D_FF = 2816
N_BRANCH = 3
BRANCH_WIDTH = 512
EPS = 1e-6

A_Q_W = A_HEADS * HEAD_DIM
A_KV_W = A_KV * HEAD_DIM
B_Q_W = B_HEADS * HEAD_DIM
B_KV_W = B_KV * HEAD_DIM
C_Q_W = C_HEADS * 2 * HEAD_DIM
C_K_W = C_KV * 2 * HEAD_DIM
C_V_W = C_KV * C_V_DIM
IN_SIZES = (A_Q_W, A_KV_W, A_KV_W, B_Q_W, B_KV_W, B_KV_W, C_Q_W, C_K_W, C_V_W, N_BRANCH * D_MODEL)
IN_COLS = sum(IN_SIZES)

kernel_name = "hybrid_gated_axial_window_diff_attn_encoder"


def rmsnorm(x, g):
    xf = x.astype(jnp.float32)
    r = lax.rsqrt(jnp.mean(xf * xf, axis=-1, keepdims=True) + EPS)
    return (xf * r * g.astype(jnp.float32)).astype(x.dtype)


def swiglu(h, w_in, w_out):
    g, u = jnp.split(h @ w_in, 2, axis=-1)
    return (jax.nn.silu(g) * u) @ w_out


def t5_bucket(rel):
    nb = NUM_BUCKETS // 2
    max_exact = nb // 2
    side = jnp.where(rel > 0, nb, 0)
    n = jnp.abs(rel)
    nf = jnp.maximum(n, 1).astype(jnp.float32)
    large = max_exact + (jnp.log(nf / max_exact) / math.log(MAX_DISTANCE / max_exact) * (nb - max_exact)).astype(jnp.int32)
    large = jnp.minimum(large, nb - 1)
    return side + jnp.where(n < max_exact, n, large)


def axial_rope_tables(seq):
    rows = seq // GRID_W
    row_ids = jnp.repeat(jnp.arange(rows), GRID_W).astype(jnp.float32)
    col_ids = jnp.tile(jnp.arange(GRID_W), rows).astype(jnp.float32)
    half = HEAD_DIM // 2
    freqs = ROPE_THETA ** (-jnp.arange(0, half, 2, dtype=jnp.float32) / half)
    ang_r = row_ids[:, None] * freqs
    ang_c = col_ids[:, None] * freqs
    return (jnp.cos(ang_r), jnp.sin(ang_r), jnp.cos(ang_c), jnp.sin(ang_c))


def rope_1d(x, cos, sin):
    x1, x2 = jnp.split(x, 2, axis=-1)
    c = cos[None, :, None, :]
    s = sin[None, :, None, :]
    return jnp.concatenate([x1 * c - x2 * s, x1 * s + x2 * c], axis=-1)


def axial_rope(x, tables):
    cos_r, sin_r, cos_c, sin_c = tables
    xf = x.astype(jnp.float32)
    half = HEAD_DIM // 2
    out = jnp.concatenate([rope_1d(xf[..., :half], cos_r, sin_r), rope_1d(xf[..., half:], cos_c, sin_c)], axis=-1)
    return out.astype(x.dtype)


def to_blocks(t):
    b, s = t.shape[:2]
    return jnp.moveaxis(t.reshape((b, s // BLOCK, BLOCK) + t.shape[2:]), 1, 0)


def mixer_a(q, k, v, qg, kg, rope):
    b, s = q.shape[:2]
    scale = HEAD_DIM ** -0.5
    q = axial_rope(rmsnorm(q, qg), rope)
    k = axial_rope(rmsnorm(k, kg), rope)
    qb = to_blocks(q.reshape(b, s, A_KV, A_HEADS // A_KV, HEAD_DIM) * scale)

    def one_block(qblk):
        sc = jnp.einsum('bqkgd,bskd->bkgqs', qblk, k).astype(jnp.float32)
        p = jax.nn.softmax(sc, axis=-1).astype(v.dtype)
        return jnp.einsum('bkgqs,bskd->bqkgd', p, v)

    o = lax.map(one_block, qb)
    return jnp.moveaxis(o, 0, 1).reshape(b, s, A_HEADS * HEAD_DIM)


def window_bias_and_mask(rel_bias, seq):
    nb = seq // BLOCK
    i = jnp.arange(BLOCK)[:, None]
    j = jnp.arange(3 * BLOCK)[None, :]
    rel = j - BLOCK - i
    in_window = jnp.abs(rel) <= WINDOW
    key_pos = jnp.arange(nb)[:, None] * BLOCK - BLOCK + jnp.arange(3 * BLOCK)[None, :]
    in_range = (key_pos >= 0) & (key_pos < seq)
    valid = in_window[None] & in_range[:, None, :]
    bias = rel_bias[:, :B_HEADS][t5_bucket(rel)].astype(jnp.float32)
    bias = bias.reshape(BLOCK, 3 * BLOCK, B_KV, B_HEADS // B_KV).transpose(2, 3, 0, 1)
    return bias, valid


def mixer_b(q, k, v, sink, bias, valid):
    b, s = q.shape[:2]
    nb = s // BLOCK
    scale = HEAD_DIM ** -0.5
    pad = ((0, 0), (BLOCK, BLOCK), (0, 0), (0, 0))
    kp = jnp.pad(k, pad).reshape(b, nb + 2, BLOCK, B_KV, HEAD_DIM)
    vp = jnp.pad(v, pad).reshape(b, nb + 2, BLOCK, B_KV, HEAD_DIM)
    kband = jnp.concatenate([kp[:, :-2], kp[:, 1:-1], kp[:, 2:]], axis=2)
    vband = jnp.concatenate([vp[:, :-2], vp[:, 1:-1], vp[:, 2:]], axis=2)
    qb = q.reshape(b, nb, BLOCK, B_KV, B_HEADS // B_KV, HEAD_DIM) * scale
    sc = jnp.einsum('bnqkgd,bnskd->bnkgqs', qb, kband).astype(jnp.float32) + bias[None, None]
    sc = jnp.where(valid[None, :, None, None], sc, -1e30)
    sk = sink.astype(jnp.float32).reshape(B_KV, B_HEADS // B_KV)[None, None, :, :, None, None]
    m = jnp.maximum(jnp.max(sc, axis=-1, keepdims=True), sk)
    e = jnp.exp(sc - m)
    p = e / (jnp.sum(e, axis=-1, keepdims=True) + jnp.exp(sk - m))
    o = jnp.einsum('bnkgqs,bnskd->bnqkgd', p.astype(v.dtype), vband)
    return o.reshape(b, s, B_HEADS * HEAD_DIM)


def mixer_c(q, k, v, lq1, lk1, lq2, lk2, subln_g, lambda_init, rel_bias):
    b, s = q.shape[:2]
    nb = s // BLOCK
    g = C_HEADS // C_KV
    scale = HEAD_DIM ** -0.5
    f32 = jnp.float32
    lam = (jnp.exp(jnp.sum(lq1.astype(f32) * lk1.astype(f32))) - jnp.exp(jnp.sum(lq2.astype(f32) * lk2.astype(f32))) + lambda_init)
    table = rel_bias[:, B_HEADS:]
    qb = to_blocks(q.reshape(b, s, C_KV, g, 2, HEAD_DIM) * scale)
    starts = jnp.arange(nb) * BLOCK
    key_pos = jnp.arange(s)

    def one_block(args):
        qblk, q0 = args
        sc = jnp.einsum('bqkgmd,bskmd->bkgmqs', qblk, k).astype(f32)
        rel = key_pos[None, :] - (q0 + jnp.arange(BLOCK))[:, None]
        bias = table[t5_bucket(rel)].astype(f32).reshape(BLOCK, s, C_KV, g).transpose(2, 3, 0, 1)
        p = jax.nn.softmax(sc + bias[None, :, :, None], axis=-1)
        attn = p[:, :, :, 0] - lam * p[:, :, :, 1]
        return jnp.einsum('bkgqs,bskd->bqkgd', attn.astype(v.dtype), v)

    o = lax.map(one_block, (qb, starts))
    o = jnp.moveaxis(o, 0, 1).reshape(b, s, C_HEADS, C_V_DIM)
    o = rmsnorm(o, subln_g) * (1.0 - lambda_init)
    return o.reshape(b, s, C_HEADS * C_V_DIM)


def setup_inputs(seed: int = 0) -> dict:
    key = jax.random.key(seed)
    ks = jax.random.split(key, 24)
    f32 = jnp.float32
    nrm = lambda k, shape, sc: jax.random.normal(k, shape, f32) * sc
    gain = lambda k, shape: 1.0 + 0.02 * jax.random.normal(k, shape, f32)
    return {
        "x": jax.random.normal(ks[0], (BATCH, SEQ, D_MODEL), f32),
        "rel_bias": nrm(ks[1], (NUM_BUCKETS, N_BIAS_HEADS), 0.5),
        "norm_ffn1": gain(ks[2], (DEPTH, D_MODEL)),
        "w_ffn1_in": nrm(ks[3], (DEPTH, D_MODEL, 2 * D_FF), D_MODEL ** -0.5),
        "w_ffn1_out": nrm(ks[4], (DEPTH, D_FF, D_MODEL), D_FF ** -0.5),
        "norm_mix": gain(ks[5], (DEPTH, D_MODEL)),
        "w_in": nrm(ks[6], (DEPTH, D_MODEL, IN_COLS), D_MODEL ** -0.5),
        "qnorm_a": gain(ks[7], (DEPTH, HEAD_DIM)),
        "knorm_a": gain(ks[8], (DEPTH, HEAD_DIM)),
        "sink_b": nrm(ks[9], (DEPTH, B_HEADS), 0.5),
        "lam_q1": nrm(ks[10], (DEPTH, HEAD_DIM), 0.1),
        "lam_k1": nrm(ks[11], (DEPTH, HEAD_DIM), 0.1),
        "lam_q2": nrm(ks[12], (DEPTH, HEAD_DIM), 0.1),
        "lam_k2": nrm(ks[13], (DEPTH, HEAD_DIM), 0.1),
        "subln_c": gain(ks[14], (DEPTH, C_V_DIM)),
        "w_branch": nrm(ks[15], (DEPTH, N_BRANCH, BRANCH_WIDTH, D_MODEL), BRANCH_WIDTH ** -0.5),
        "w_out": nrm(ks[16], (DEPTH, D_MODEL, D_MODEL), D_MODEL ** -0.5),
        "norm_ffn2": gain(ks[17], (DEPTH, D_MODEL)),
        "w_ffn2_in": nrm(ks[18], (DEPTH, D_MODEL, 2 * D_FF), D_MODEL ** -0.5),
        "w_ffn2_out": nrm(ks[19], (DEPTH, D_FF, D_MODEL), D_FF ** -0.5),
        "norm_final": gain(ks[20], (D_MODEL,)),
    }


def reference(x, rel_bias, norm_ffn1, w_ffn1_in, w_ffn1_out, norm_mix, w_in, qnorm_a, knorm_a, sink_b, lam_q1, lam_k1, lam_q2, lam_k2, subln_c, w_branch, w_out, norm_ffn2, w_ffn2_in, w_ffn2_out, norm_final):
    b, s, _ = x.shape
    rope = axial_rope_tables(s)
    win_bias, win_valid = window_bias_and_mask(rel_bias, s)
    split_points = np.cumsum(IN_SIZES)[:-1].tolist()
    for l in range(DEPTH):
        lambda_init = 0.8 - 0.6 * math.exp(-0.3 * l)
        x = x + 0.5 * swiglu(rmsnorm(x, norm_ffn1[l]), w_ffn1_in[l], w_ffn1_out[l])
        h = rmsnorm(x, norm_mix[l])
        qa, ka, va, qb_, kb, vb, qc, kc, vc, gate_logits = jnp.split(h @ w_in[l], split_points, axis=-1)
        y_a = mixer_a(qa.reshape(b, s, A_HEADS, HEAD_DIM), ka.reshape(b, s, A_KV, HEAD_DIM), va.reshape(b, s, A_KV, HEAD_DIM), qnorm_a[l], knorm_a[l], rope)
        y_b = mixer_b(qb_.reshape(b, s, B_HEADS, HEAD_DIM), kb.reshape(b, s, B_KV, HEAD_DIM), vb.reshape(b, s, B_KV, HEAD_DIM), sink_b[l], win_bias, win_valid)
        y_c = mixer_c(qc.reshape(b, s, C_HEADS, 2, HEAD_DIM), kc.reshape(b, s, C_KV, 2, HEAD_DIM), vc.reshape(b, s, C_KV, C_V_DIM), lam_q1[l], lam_k1[l], lam_q2[l], lam_k2[l], subln_c[l], lambda_init, rel_bias)
        ys = jnp.stack([y_a, y_b, y_c], axis=2)
        branches = jnp.einsum('bsnw,nwd->bsnd', ys, w_branch[l])
        gates = jax.nn.sigmoid(gate_logits.reshape(b, s, N_BRANCH, D_MODEL))
        merged = jnp.sum(gates * branches, axis=2)
        x = x + merged @ w_out[l]
        x = x + 0.5 * swiglu(rmsnorm(x, norm_ffn2[l]), w_ffn2_in[l], w_ffn2_out[l])
    return rmsnorm(x, norm_final)
```

```cpp
#include <hip/hip_runtime.h>
#include <hip/hip_cooperative_groups.h>
#include <cstdio>
#include <cstdint>
namespace cg = cooperative_groups;
__device__ __forceinline__ int opaque_tid() { int t = threadIdx.x; asm volatile("" : "+v"(t)); return t; }
namespace pg8 {
#define PG8_LAS __attribute__((address_space(3)))
typedef unsigned short bf16_t;
typedef short bf16x8 __attribute__((ext_vector_type(8)));
typedef float f32x4 __attribute__((ext_vector_type(4)));
typedef unsigned u32x4 __attribute__((ext_vector_type(4)));
constexpr int BM = 256, BK = 64, HALF = 128, HTB = HALF * BK * 2  , STAGE_BYTES = 8 * HTB, NXCD = 8, WGM = 8;

__host__ __device__ __forceinline__ int lds_byte(int r, int c) { const int st = (r >> 4) * 2 + (c >> 5), rr = r & 15, cc = c & 31, ob = rr * 64 + cc * 2; return st * 1024 + (ob ^ (((ob >> 9) & 1) << 5)); }
__host__ __device__ __forceinline__ void stage_rc(int b, int& R, int& C) { const int st = b / 1024, sb = b % 1024, swz = sb ^ (((sb >> 9) & 1) << 5); R = (st >> 1) * 16 + swz / 64; C = (st & 1) * 32 + (swz % 64) / 2; }
__host__ __device__ __forceinline__ int perm32(int rho) { const int n = rho >> 4, i = rho & 15; return 8 * (i >> 2) + 4 * n + (i & 3); }

struct Unit { int pm, pn; };
struct Gemm { const bf16_t* A; const bf16_t* Bt; int M, N, K; int lda, ldb; int agrp, astride; };

struct StaticOrder {
    int nM, nN, nwg, G, c;
    __host__ __device__ void init(int M, int N, int G_, int c_) { nM = M / BM; nN = N / BM; nwg = nM * nN; G = G_; c = c_; }
    __host__ __device__ bool next(int i, Unit& u) const {
        const long L = (long)i * G + c; if (L >= nwg) return false;
        int wgid = (int)L; { const int q = nwg / NXCD, r = nwg % NXCD, xcd = wgid % NXCD, off = wgid / NXCD; wgid = (xcd < r ? xcd * (q + 1) : r * (q + 1) + (xcd - r) * q) + off; }
        const int nig = WGM * nN, gid = wgid / nig, fm = gid * WGM, gsz = (nM - fm) < WGM ? (nM - fm) : WGM;
        u.pm = fm + ((wgid % nig) % gsz); u.pn = (wgid % nig) / gsz; return true;
    }
    __device__ __forceinline__ void a_ready(const Unit&) const {}
    __device__ __forceinline__ void done(const Unit&) const {}
};


__device__ __forceinline__ unsigned cvt_pk_bf16(float lo, float hi) { unsigned r; asm volatile("v_cvt_pk_bf16_f32 %0, %1, %2" : "=v"(r) : "v"(lo), "v"(hi)); return r; }
typedef float f32x2 __attribute__((ext_vector_type(2)));

typedef unsigned u32x2 __attribute__((ext_vector_type(2)));
constexpr float RMS_EPS = 1e-6f, K_LOG2E = 1.4426950408889634f, K_C2 = 0.125f * 1.4426950408889634f;
__device__ __forceinline__ float sigm(float v) { return __builtin_amdgcn_rcpf(1.0f + __builtin_amdgcn_exp2f(-v * K_LOG2E)); }
struct EpiSwiGLU {
    static constexpr bool PERM = true, AFTER_DRAIN = false;
    bf16_t* O; const float* ss; int ldo;
    __device__ __forceinline__ void operator()(const f32x4 (&acc)[2][2][4][2], const Unit& u, int wr, int wc, int fr, int fq) const {
        const int row0 = u.pm * BM + wr * 64 + fr, col0 = u.pn * HALF + wc * 32 + 8 * fq;
#pragma unroll
        for (int ai = 0; ai < 2; ++ai)
#pragma unroll
            for (int m = 0; m < 4; ++m) { const int row = row0 + ai * HALF + m * 16; const float rs = __builtin_amdgcn_rsqf(ss[row] * (1.0f / 1024.0f) + RMS_EPS);
                float o[8];
#pragma unroll
                for (int n = 0; n < 2; ++n)
#pragma unroll
                    for (int e = 0; e < 4; ++e) { const float g = acc[ai][0][m][n][e] * rs, uu = acc[ai][1][m][n][e] * rs; o[4 * n + e] = g * sigm(g) * uu; }
                u32x4 w; w.x = cvt_pk_bf16(o[0], o[1]); w.y = cvt_pk_bf16(o[2], o[3]); w.z = cvt_pk_bf16(o[4], o[5]); w.w = cvt_pk_bf16(o[6], o[7]);
                *(u32x4*)(O + (size_t)row * ldo + col0) = w; asm volatile("" ::: "memory"); }
    }
};
struct EpiResid {
    static constexpr bool PERM = true, AFTER_DRAIN = false;
    const float* xin; float* xout; bf16_t* xb; float* ssout; float scale;
    __device__ __forceinline__ void operator()(const f32x4 (&acc)[2][2][4][2], const Unit& u, int wr, int wc, int fr, int fq) const {
        const int row0 = u.pm * BM + wr * 64 + fr, col0 = u.pn * BM + wc * 32 + 8 * fq;
#pragma unroll
        for (int ai = 0; ai < 2; ++ai) {
            f32x4 pre[4][2][2];
#pragma unroll
            for (int m = 0; m < 4; ++m)
#pragma unroll
                for (int bj = 0; bj < 2; ++bj)
#pragma unroll
                    for (int n = 0; n < 2; ++n) pre[m][bj][n] = *(const f32x4*)(xin + (size_t)(row0 + ai * HALF + m * 16) * 1024 + col0 + bj * HALF + n * 4);
            asm volatile("" ::: "memory");
#pragma unroll
            for (int m = 0; m < 4; ++m) { const int row = row0 + ai * HALF + m * 16; float s = 0.f;
#pragma unroll
                for (int bj = 0; bj < 2; ++bj) { const size_t off = (size_t)row * 1024 + col0 + bj * HALF;
                    const f32x4 o0 = pre[m][bj][0] + acc[ai][bj][m][0] * scale, o1 = pre[m][bj][1] + acc[ai][bj][m][1] * scale;
                    *(f32x4*)(xout + off) = o0; *(f32x4*)(xout + off + 4) = o1;
                    if (xb) { u32x4 w; w.x = cvt_pk_bf16(o0[0], o0[1]); w.y = cvt_pk_bf16(o0[2], o0[3]); w.z = cvt_pk_bf16(o1[0], o1[1]); w.w = cvt_pk_bf16(o1[2], o1[3]); *(u32x4*)(xb + off) = w; }
                    s += ((o0[0] * o0[0] + o0[1] * o0[1]) + (o0[2] * o0[2] + o0[3] * o0[3])) + ((o1[0] * o1[0] + o1[1] * o1[1]) + (o1[2] * o1[2] + o1[3] * o1[3])); }
                s += __shfl_xor(s, 16); s += __shfl_xor(s, 32);
                if (fq == 0) atomicAdd(ssout + row, s); }
            asm volatile("" ::: "memory");
        }
    }
};
struct EpiProj {
    static constexpr bool PERM = true, AFTER_DRAIN = false;
    bf16_t* P; float* QK; bf16_t* GT; const float* ss;
    __device__ __forceinline__ void operator()(const f32x4 (&acc)[2][2][4][2], const Unit& u, int wr, int wc, int fr, int fq) const {
        const int row0 = u.pm * BM + wr * 64 + fr, cl = wc * 32 + 8 * fq, pn = u.pn;
#pragma unroll
        for (int ai = 0; ai < 2; ++ai)
#pragma unroll
            for (int m = 0; m < 4; ++m) { const int row = row0 + ai * HALF + m * 16; const float rs = __builtin_amdgcn_rsqf(ss[row] * (1.0f / 1024.0f) + RMS_EPS);
#pragma unroll
                for (int bj = 0; bj < 2; ++bj) { const int ct = pn * BM + bj * HALF; f32x4 v0 = acc[ai][bj][m][0] * rs, v1 = acc[ai][bj][m][1] * rs;
                    if (pn >= 10) {
#pragma unroll
                        for (int e = 0; e < 4; ++e) { v0[e] = sigm(v0[e]); v1[e] = sigm(v1[e]); }
                        u32x4 w; w.x = cvt_pk_bf16(v0[0], v0[1]); w.y = cvt_pk_bf16(v0[2], v0[3]); w.z = cvt_pk_bf16(v1[0], v1[1]); w.w = cvt_pk_bf16(v1[2], v1[3]);
                        *(u32x4*)(GT + (size_t)row * 3072 + (ct - 2560) + cl) = w;
                    } else if (ct < 640) {
                        float* q = QK + (size_t)row * 640 + ct + cl; *(f32x4*)q = v0; *(f32x4*)(q + 4) = v1;
                    } else {
                        const float sc = ((ct >= 768 && ct < 1280) || (ct >= 1536 && ct < 2048)) ? K_C2 : 1.0f; v0 = v0 * sc; v1 = v1 * sc;
                        u32x4 w; w.x = cvt_pk_bf16(v0[0], v0[1]); w.y = cvt_pk_bf16(v0[2], v0[3]); w.z = cvt_pk_bf16(v1[0], v1[1]); w.w = cvt_pk_bf16(v1[2], v1[3]);
                        *(u32x4*)(P + (size_t)row * 2560 + ct + cl) = w;
                    } } asm volatile("" ::: "memory"); }
    }
};
struct EpiGate {
    static constexpr bool PERM = true, AFTER_DRAIN = false;
    bf16_t* GT;
    __device__ __forceinline__ void operator()(const f32x4 (&acc)[2][2][4][2], const Unit& u, int wr, int wc, int fr, int fq) const {
        const int row0 = u.pm * BM + wr * 64 + fr, cl = u.pn * BM + wc * 32 + 8 * fq;
#pragma unroll
        for (int ai = 0; ai < 2; ++ai)
#pragma unroll
            for (int m = 0; m < 4; ++m) { const int row = row0 + ai * HALF + m * 16;
#pragma unroll
                for (int bj = 0; bj < 2; ++bj) { bf16_t* p = GT + (size_t)row * 3072 + cl + bj * HALF; const u32x4 gv = *(const u32x4*)p;
                    const f32x4 v0 = acc[ai][bj][m][0], v1 = acc[ai][bj][m][1]; u32x4 w;
                    w.x = cvt_pk_bf16(v0[0] * __uint_as_float(gv.x << 16), v0[1] * __uint_as_float(gv.x & 0xffff0000u));
                    w.y = cvt_pk_bf16(v0[2] * __uint_as_float(gv.y << 16), v0[3] * __uint_as_float(gv.y & 0xffff0000u));
                    w.z = cvt_pk_bf16(v1[0] * __uint_as_float(gv.z << 16), v1[1] * __uint_as_float(gv.z & 0xffff0000u));
                    w.w = cvt_pk_bf16(v1[2] * __uint_as_float(gv.w << 16), v1[3] * __uint_as_float(gv.w & 0xffff0000u));
                    *(u32x4*)p = w; } asm volatile("" ::: "memory"); }
    }
};
struct BranchOrder {
    int G, c;
    __device__ __forceinline__ bool next(int i, Unit& u) const { const int tile = c + (i / 3) * G; if (tile >= 256) return false; u.pm = tile >> 2; u.pn = 4 * (i % 3) + (tile & 3); return true; }
    __device__ __forceinline__ void a_ready(const Unit&) const {}
    __device__ __forceinline__ void done(const Unit&) const {}
};
struct EpiGateSum {
    static constexpr bool PERM = true, AFTER_DRAIN = false;
    const bf16_t* GT; bf16_t* MB;
    __device__ __forceinline__ void operator()(const f32x4 (&acc)[2][2][4][2], const Unit& u, int wr, int wc, int fr, int fq) const {
        const int row0 = u.pm * BM + wr * 64 + fr, cg = u.pn * BM + wc * 32 + 8 * fq, cm = (u.pn & 3) * BM + wc * 32 + 8 * fq, br = u.pn >> 2;
#pragma unroll
        for (int ai = 0; ai < 2; ++ai)
#pragma unroll
            for (int mp = 0; mp < 4; mp += 2) {
                u32x4 gv[2][2], pv[2][2];
#pragma unroll
                for (int mm = 0; mm < 2; ++mm)
#pragma unroll
                    for (int bj = 0; bj < 2; ++bj) { const int row = row0 + ai * HALF + (mp + mm) * 16;
                        gv[mm][bj] = *(const u32x4*)(GT + (size_t)row * 3072 + cg + bj * HALF);
                        if (br > 0) pv[mm][bj] = *(const u32x4*)(MB + (size_t)row * 1024 + cm + bj * HALF); }
                asm volatile("" ::: "memory");
#pragma unroll
                for (int mm = 0; mm < 2; ++mm)
#pragma unroll
                    for (int bj = 0; bj < 2; ++bj) { const int m = mp + mm, row = row0 + ai * HALF + m * 16; const u32x4 g = gv[mm][bj];
                        f32x4 v0 = acc[ai][bj][m][0], v1 = acc[ai][bj][m][1];
                        v0[0] *= __uint_as_float(g.x << 16); v0[1] *= __uint_as_float(g.x & 0xffff0000u); v0[2] *= __uint_as_float(g.y << 16); v0[3] *= __uint_as_float(g.y & 0xffff0000u);
                        v1[0] *= __uint_as_float(g.z << 16); v1[1] *= __uint_as_float(g.z & 0xffff0000u); v1[2] *= __uint_as_float(g.w << 16); v1[3] *= __uint_as_float(g.w & 0xffff0000u);
                        if (br > 0) { const u32x4 p = pv[mm][bj];
                            v0[0] += __uint_as_float(p.x << 16); v0[1] += __uint_as_float(p.x & 0xffff0000u); v0[2] += __uint_as_float(p.y << 16); v0[3] += __uint_as_float(p.y & 0xffff0000u);
                            v1[0] += __uint_as_float(p.z << 16); v1[1] += __uint_as_float(p.z & 0xffff0000u); v1[2] += __uint_as_float(p.w << 16); v1[3] += __uint_as_float(p.w & 0xffff0000u); }
                        u32x4 w; w.x = cvt_pk_bf16(v0[0], v0[1]); w.y = cvt_pk_bf16(v0[2], v0[3]); w.z = cvt_pk_bf16(v1[0], v1[1]); w.w = cvt_pk_bf16(v1[2], v1[3]);
                        *(u32x4*)(MB + (size_t)row * 1024 + cm + bj * HALF) = w; }
                asm volatile("" ::: "memory");
            }
    }
};
template <class Epi, class Sched, bool ALIGN_EPI = false, bool SP2 = false>
__device__ __forceinline__ void gemm_phase(PG8_LAS unsigned char* lds, const Gemm g, const Sched& S, const Epi& E) {
    const int tid = opaque_tid(), wid = __builtin_amdgcn_readfirstlane(tid >> 6), lane = tid & 63, wr = wid >> 2, wc = wid & 3, fr = lane & 15, fq = lane >> 4;
    const int K = g.K, nt = K / BK;
    unsigned voffA[2], voffB[2];
#pragma unroll
    for (int i = 0; i < 2; ++i) { int R, C; stage_rc(tid * 16 + i * 8192, R, C); const int Rb = Epi::PERM ? ((R & ~31) + perm32(R & 31)) : R;
        voffA[i] = (unsigned)(R * g.lda + C) * 2u; voffB[i] = (unsigned)(Rb * g.ldb + C) * 2u; }
    const size_t kstep = (size_t)(BK * 2);
    const size_t hstepA = (size_t)HALF * g.lda * 2, hstepB = (size_t)HALF * g.ldb * 2;
    const size_t tstepA = 2 * hstepA, tstepB = 2 * hstepB;
    const unsigned ldsw = (unsigned)wid * 1024u;
    const int aoff = lds_byte(wr * 64 + fr, fq * 8), boff = lds_byte(wc * 32 + fr, fq * 8);
#define PG8_SA(b, h) (((b) * 2 + (h)) * HTB)
#define PG8_SB(b, h) ((4 + (b) * 2 + (h)) * HTB)
#define PG8_STAGE(bufoff, gbase, voff) do { _Pragma("unroll") for (int _i = 0; _i < 2; ++_i) \
        __builtin_amdgcn_global_load_lds((const unsigned*)((const char*)(gbase) + (voff)[_i]), (PG8_LAS unsigned*)(lds + (bufoff) + ldsw + _i * 8192), 16, 0, 0); } while (0)
#define PG8_LDA(dst, b, h) do { _Pragma("unroll") for (int m = 0; m < 4; ++m) _Pragma("unroll") for (int k = 0; k < 2; ++k) dst[m][k] = *(const PG8_LAS bf16x8*)(lds + PG8_SA(b, h) + aoff + m * 2048 + k * 1024); } while (0)
#define PG8_LDB(dst, b, h) do { _Pragma("unroll") for (int n = 0; n < 2; ++n) _Pragma("unroll") for (int k = 0; k < 2; ++k) dst[n][k] = *(const PG8_LAS bf16x8*)(lds + PG8_SB(b, h) + boff + n * 2048 + k * 1024); } while (0)
#define PG8_MMA(ai, bj, At, Bt) do { __builtin_amdgcn_s_setprio(1); _Pragma("unroll") for (int m = 0; m < 4; ++m) _Pragma("unroll") for (int n = 0; n < 2; ++n) _Pragma("unroll") for (int k = 0; k < 2; ++k) \
        acc[ai][bj][m][n] = __builtin_amdgcn_mfma_f32_16x16x32_bf16(Bt[n][k], At[m][k], acc[ai][bj][m][n], 0, 0, 0); __builtin_amdgcn_s_setprio(0); } while (0)
#define PG8_WAIT_V(n) asm volatile("s_waitcnt vmcnt(" #n ")" ::: "memory")
#define PG8_WAIT_L(n) asm volatile("s_waitcnt lgkmcnt(" #n ")" ::: "memory")
#define PG8_BAR __builtin_amdgcn_s_barrier()
#define PG8_SCHED __builtin_amdgcn_sched_barrier(0)
    Unit cur, nxt; int ui = 0;
    if (!S.next(0, cur)) return;
    f32x4 acc[2][2][4][2];
#pragma unroll
    for (int a = 0; a < 2; ++a)
#pragma unroll
        for (int b = 0; b < 2; ++b)
#pragma unroll
            for (int m = 0; m < 4; ++m)
#pragma unroll
                for (int n = 0; n < 2; ++n) acc[a][b][m][n] = (f32x4){0.f, 0.f, 0.f, 0.f};
    bf16x8 At[4][2], B0[2][2], B1[2][2];
    const char* cA = (const char*)g.A + (size_t)cur.pm * tstepA + (size_t)(cur.pn / g.agrp) * g.astride * 2; const char* cB = (const char*)g.Bt + (size_t)cur.pn * tstepB;
    S.a_ready(cur);
    if constexpr (SP2) {
        PG8_STAGE(PG8_SB(0, 0), cB, voffB); PG8_STAGE(PG8_SB(0, 1), cB + hstepB, voffB); PG8_STAGE(PG8_SA(0, 0), cA, voffA); PG8_STAGE(PG8_SA(0, 1), cA + hstepA, voffA);
        if (wr == 1) PG8_BAR;
        PG8_WAIT_V(2); PG8_BAR;
        PG8_STAGE(PG8_SB(1, 0), cB + kstep, voffB); PG8_STAGE(PG8_SA(1, 0), cA + kstep, voffA); PG8_STAGE(PG8_SB(1, 1), cB + hstepB + kstep, voffB);
        PG8_WAIT_V(6); PG8_BAR;
    } else {
        PG8_STAGE(PG8_SB(0, 0), cB, voffB); PG8_STAGE(PG8_SA(0, 0), cA, voffA); PG8_STAGE(PG8_SB(0, 1), cB + hstepB, voffB); PG8_STAGE(PG8_SA(0, 1), cA + hstepA, voffA);
        if (wr == 1) PG8_BAR;
        PG8_WAIT_V(4); PG8_BAR;
        PG8_STAGE(PG8_SB(1, 0), cB + kstep, voffB); PG8_STAGE(PG8_SA(1, 0), cA + kstep, voffA); PG8_STAGE(PG8_SB(1, 1), cB + hstepB + kstep, voffB);
        PG8_WAIT_V(6); PG8_BAR;
    }
    for (;;) {
        const bool has_next = S.next(ui + 1, nxt);
        const char* nA = has_next ? (const char*)g.A + (size_t)nxt.pm * tstepA + (size_t)(nxt.pn / g.agrp) * g.astride * 2 : cA; const char* nB = has_next ? (const char*)g.Bt + (size_t)nxt.pn * tstepB : cB;
        for (int t = 0; t < nt; t += 2) {
            const bool last = (t == nt - 2);
            const char* a1 = cA + (size_t)(t + 1) * kstep;
            const char* a2 = last ? nA : cA + (size_t)(t + 2) * kstep; const char* b2 = last ? nB : cB + (size_t)(t + 2) * kstep;
            const char* a3 = a2 + kstep; const char* b3 = b2 + kstep;
            if (last && has_next) S.a_ready(nxt);
            if constexpr (SP2) {
            PG8_LDB(B0, 0, 0); PG8_LDB(B1, 0, 1); PG8_SCHED; PG8_LDA(At, 0, 0); PG8_STAGE(PG8_SA(1, 1), a1 + hstepA, voffA);
            PG8_WAIT_V(8); PG8_WAIT_L(0); PG8_BAR; PG8_MMA(0, 0, At, B0); PG8_MMA(0, 1, At, B1); PG8_BAR; PG8_SCHED;
            PG8_LDA(At, 0, 1); PG8_STAGE(PG8_SB(0, 0), b2, voffB); PG8_STAGE(PG8_SB(0, 1), b2 + hstepB, voffB); PG8_STAGE(PG8_SA(0, 0), a2, voffA);
            PG8_WAIT_V(8); PG8_WAIT_L(0); PG8_BAR; PG8_MMA(1, 0, At, B0); PG8_MMA(1, 1, At, B1); PG8_BAR; PG8_SCHED;
            PG8_LDB(B0, 1, 0); PG8_LDB(B1, 1, 1); PG8_SCHED; PG8_LDA(At, 1, 0); PG8_STAGE(PG8_SA(0, 1), a2 + hstepA, voffA);
            PG8_WAIT_V(8); PG8_WAIT_L(0); PG8_BAR; PG8_MMA(0, 0, At, B0); PG8_MMA(0, 1, At, B1); PG8_BAR; PG8_SCHED;
            PG8_LDA(At, 1, 1); PG8_STAGE(PG8_SB(1, 0), b3, voffB); PG8_STAGE(PG8_SB(1, 1), b3 + hstepB, voffB); PG8_STAGE(PG8_SA(1, 0), a3, voffA);
            PG8_WAIT_V(8); PG8_WAIT_L(0); PG8_BAR; PG8_MMA(1, 0, At, B0); PG8_MMA(1, 1, At, B1); PG8_BAR; PG8_SCHED;
            } else {
            PG8_LDB(B0, 0, 0); PG8_SCHED; PG8_LDA(At, 0, 0); PG8_STAGE(PG8_SA(1, 1), a1 + hstepA, voffA);
            PG8_WAIT_L(8); PG8_BAR; PG8_WAIT_L(0); PG8_MMA(0, 0, At, B0); PG8_BAR; PG8_SCHED;
            PG8_LDB(B1, 0, 1); PG8_STAGE(PG8_SB(0, 0), b2, voffB);
            PG8_BAR; PG8_WAIT_L(0); PG8_MMA(0, 1, At, B1); PG8_BAR;
            PG8_LDA(At, 0, 1); PG8_STAGE(PG8_SA(0, 0), a2, voffA);
            PG8_BAR; PG8_WAIT_L(0); PG8_MMA(1, 0, At, B0); PG8_BAR; PG8_SCHED;
            PG8_STAGE(PG8_SB(0, 1), b2 + hstepB, voffB);
            PG8_WAIT_V(6); PG8_BAR; PG8_MMA(1, 1, At, B1); PG8_BAR;
            PG8_LDB(B0, 1, 0); PG8_SCHED; PG8_LDA(At, 1, 0); PG8_STAGE(PG8_SA(0, 1), a2 + hstepA, voffA);
            PG8_WAIT_L(8); PG8_BAR; PG8_WAIT_L(0); PG8_MMA(0, 0, At, B0); PG8_BAR; PG8_SCHED;
            PG8_LDB(B1, 1, 1); PG8_STAGE(PG8_SB(1, 0), b3, voffB);
            PG8_BAR; PG8_WAIT_L(0); PG8_MMA(0, 1, At, B1); PG8_BAR;
            PG8_LDA(At, 1, 1); PG8_STAGE(PG8_SA(1, 0), a3, voffA);
            PG8_BAR; PG8_WAIT_L(0); PG8_MMA(1, 0, At, B0); PG8_BAR; PG8_SCHED;
            PG8_STAGE(PG8_SB(1, 1), b3 + hstepB, voffB);
            PG8_WAIT_V(6); PG8_BAR; PG8_MMA(1, 1, At, B1); PG8_BAR;
            }
        }
        if constexpr (ALIGN_EPI) { if (wr == 0) PG8_BAR; }
        if constexpr (!Epi::AFTER_DRAIN) { E(acc, cur, wr, wc, fr, fq); S.done(cur); }
        if (!has_next) break;
#pragma unroll
        for (int a = 0; a < 2; ++a)
#pragma unroll
            for (int b = 0; b < 2; ++b)
#pragma unroll
                for (int m = 0; m < 4; ++m)
#pragma unroll
                    for (int n = 0; n < 2; ++n) acc[a][b][m][n] = (f32x4){0.f, 0.f, 0.f, 0.f};
        cur = nxt; cA = nA; cB = nB; ++ui;
        if constexpr (ALIGN_EPI) { if (wr == 1) PG8_BAR; }
    }
    PG8_WAIT_V(0);
    if constexpr (!ALIGN_EPI) { if (wr == 0) PG8_BAR; }
    PG8_BAR;
    if constexpr (Epi::AFTER_DRAIN) { E.fused(acc, cur, wr, wc, fr, fq, lds, wid, lane); S.done(cur); }
#undef PG8_SA
#undef PG8_SB
#undef PG8_STAGE
#undef PG8_LDA
#undef PG8_LDB
#undef PG8_MMA
#undef PG8_WAIT_V
#undef PG8_WAIT_L
#undef PG8_BAR
#undef PG8_SCHED
}
}

#define LAS __attribute__((address_space(3)))
typedef unsigned short bf16_t;
constexpr int D = 1024, NBATCH = 2, SEQ = 16384, T = NBATCH * SEQ, DFF = 2816, NIN = 5632, PW = 2560, GW = 3072, QKW = 640;
constexpr float EPS = 1e-6f, LOG2E = 1.4426950408889634f, C2 = 0.125f * 1.4426950408889634f;
constexpr size_t MiB = 1u << 20;
constexpr size_t WS_SS = 0;
constexpr size_t WS_LAM = 1 * MiB;
constexpr size_t WS_LUT = 1 * MiB + 256;
constexpr size_t WS_BAR = MiB + MiB / 2, WS_BAR_BYTES = 16384;
constexpr size_t WS_W = 2 * MiB, W_LAYER = 53 * MiB;
constexpr size_t W_1IN = 0, W_1OUT = 11 * MiB, W_IN = 16 * MiB + MiB / 2, W_B = 27 * MiB + MiB / 2, W_O3 = 30 * MiB + MiB / 2, W_2IN = 36 * MiB + MiB / 2, W_2OUT = 47 * MiB + MiB / 2;
constexpr size_t WS_XB = 108 * MiB;
constexpr size_t WS_R2 = 172 * MiB;
constexpr size_t WS_P = 348 * MiB;
constexpr size_t WS_QK = 428 * MiB;
constexpr size_t WS_O1 = 468 * MiB;
constexpr size_t WS_END = 500 * MiB;
constexpr int LDS_BYTES = 147456;

typedef unsigned v4u __attribute__((ext_vector_type(4)));
typedef float f32x4 __attribute__((ext_vector_type(4)));
#define LDS_WAIT() asm volatile("s_waitcnt lgkmcnt(0)" ::: "memory")
__device__ __forceinline__ unsigned f2bf(float f) { unsigned u = __float_as_uint(f); return (u + 0x7fffu + ((u >> 16) & 1u)) >> 16; }
__device__ __forceinline__ unsigned pk2(float lo, float hi) { return f2bf(lo) | (f2bf(hi) << 16); }
__device__ __forceinline__ float wave_sum(float v) {
#pragma unroll
    for (int o = 1; o < 64; o <<= 1) v += __shfl_xor(v, o);
    return v;
}

namespace att {
typedef short bf16x8 __attribute__((ext_vector_type(8)));
typedef short s16x4 __attribute__((ext_vector_type(4)));
typedef float f32x16 __attribute__((ext_vector_type(16)));
typedef unsigned u32x4 __attribute__((ext_vector_type(4)));
typedef unsigned u32x2 __attribute__((ext_vector_type(2)));
typedef float f32x2_t __attribute__((ext_vector_type(2)));
typedef __bf16 bf16x2_t __attribute__((ext_vector_type(2)));
__device__ __forceinline__ unsigned cvtpk(float lo, float hi) { f32x2_t v = {lo, hi}; bf16x2_t b = __builtin_convertvector(v, bf16x2_t); return __builtin_bit_cast(unsigned, b); }
__device__ __forceinline__ int crow(int r, int hi) { return (r & 3) + 8 * (r >> 2) + 4 * hi; }
__device__ __forceinline__ float swapmax(float m) { auto rr = __builtin_amdgcn_permlane32_swap(__float_as_uint(m), __float_as_uint(m), false, false); return fmaxf(__uint_as_float(rr[0]), __uint_as_float(rr[1])); }
__device__ __forceinline__ float swapsum(float m) { auto rr = __builtin_amdgcn_permlane32_swap(__float_as_uint(m), __float_as_uint(m), false, false); return __uint_as_float(rr[0]) + __uint_as_float(rr[1]); }
typedef short v4i16_t __attribute__((ext_vector_type(4)));
__device__ __forceinline__ s16x4 vtr(const LAS unsigned char* p) { return __builtin_bit_cast(s16x4, __builtin_amdgcn_ds_read_tr16_b64_v4i16((LAS v4i16_t*)p)); }
constexpr int K_OFF = 0, V_OFF = 32768, LUT_OFF = 98304;
__device__ __forceinline__ void glds16(const void* gsrc, unsigned lds_dst) { unsigned keep;
    asm volatile("s_mov_b32 %0, m0\n\ts_mov_b32 m0, %2\n\ts_nop 0\n\tglobal_load_lds_dwordx4 %1, off\n\ts_mov_b32 m0, %0" : "=&s"(keep) : "v"(gsrc), "s"(lds_dst) : "memory"); }
constexpr float THR = 4.0f;
#define ATT_BAR() asm volatile("s_waitcnt lgkmcnt(0)\n\ts_barrier" ::: "memory")
#define ATT_BAR_S(a, b) asm volatile("s_waitcnt lgkmcnt(0)\n\ts_barrier" : "+v"(a), "+v"(b) :: "memory")
#define ATT_BAR_P(p) asm volatile("s_barrier" : "+v"(p[0]), "+v"(p[1]), "+v"(p[2]), "+v"(p[3]) :: "memory")
__device__ __forceinline__ float max3f(float a, float b, float c) { float r; asm("v_max3_f32 %0, %1, %2, %3" : "=v"(r) : "v"(a), "v"(b), "v"(c)); return r; }

template <int NDB>
__device__ __forceinline__ void pv_block(const LAS unsigned char* Vb, const bf16x8 (&pf)[4], f32x16 (&o)[NDB]) {
    bf16x8 vf[2][NDB];
#pragma unroll
    for (int db = 0; db < NDB; ++db) { const s16x4 lo = vtr(Vb + db * 4096), hh = vtr(Vb + db * 4096 + 512); vf[0][db] = (bf16x8){lo[0], lo[1], lo[2], lo[3], hh[0], hh[1], hh[2], hh[3]}; }
    __builtin_amdgcn_sched_barrier(0);
#pragma unroll
    for (int ks = 0; ks < 4; ++ks) {
        if (ks < 3) {
#pragma unroll
            for (int db = 0; db < NDB; ++db) { const s16x4 lo = vtr(Vb + db * 4096 + (ks + 1) * 1024), hh = vtr(Vb + db * 4096 + (ks + 1) * 1024 + 512); vf[(ks + 1) & 1][db] = (bf16x8){lo[0], lo[1], lo[2], lo[3], hh[0], hh[1], hh[2], hh[3]}; }
        }
#pragma unroll
        for (int db = 0; db < NDB; ++db) o[db] = __builtin_amdgcn_mfma_f32_32x32x16_bf16(vf[ks & 1][db], pf[ks], o[db], 0, 0, 0);
        __builtin_amdgcn_sched_barrier(0);
    }
}

template <int DV, int MODE>
__device__ __forceinline__ void attn_pass(LAS unsigned char* lds, const bf16_t* __restrict__ Kp, const bf16_t* __restrict__ Vp, int kt0, int kt1,
                                          const bf16x8 (&qr)[4], f32x16 (&o)[DV / 32], float& m_io, float& l_io, int qpos, float cL, float cR) {
    constexpr int NDB = DV / 32, NVP = DV / 64;
    const int tid = opaque_tid(), lane = tid & 63, wid = __builtin_amdgcn_readfirstlane(tid >> 6), r32 = lane & 31, hi = lane >> 5;
    const int grp = __builtin_amdgcn_readfirstlane((int)((const volatile LAS unsigned*)(lds + 131072 + 64))[8 + wid]);
    const LAS float* lut = (const LAS float*)(lds + LUT_OFF);
    const unsigned ldsb = (unsigned)(uintptr_t)lds;
    const bf16_t* ksrc = Kp + (size_t)lane * PW + wid * 8;
    const unsigned kdst = ldsb + K_OFF + wid * 1024;
    const bf16_t* vsrc[NVP]; unsigned vdst[NVP];
#pragma unroll
    for (int j = 0; j < NVP; ++j) { const int p = wid + 8 * j, db = p >> 2, kvq = p & 3; vsrc[j] = Vp + (size_t)(16 * kvq + (lane >> 2)) * PW + db * 32 + (lane & 3) * 8; vdst[j] = ldsb + V_OFF + p * 1024; }
    const int nt = kt1 - kt0;
#define DMA_K(tt, slot) glds16(ksrc + (size_t)(tt) * 64 * PW, (unsigned)__builtin_amdgcn_readfirstlane(kdst + (slot) * 8192))
#define DMA_V(tt, slot) do { _Pragma("unroll") for (int j_ = 0; j_ < NVP; ++j_) glds16(vsrc[j_] + (size_t)(tt) * 64 * PW, (unsigned)__builtin_amdgcn_readfirstlane(vdst[j_] + (slot) * 16384)); } while (0)
    DMA_K(kt0, 0); DMA_V(kt0, 0); DMA_K(kt0 + 1, 1); DMA_V(kt0 + 1, 1); DMA_K(kt0 + 2, 2);
    asm volatile("s_waitcnt vmcnt(0)" ::: "memory");
    __syncthreads();
    float m = (MODE == 2) ? -1e30f : 0.f, l = 0.f;
#pragma unroll
    for (int db = 0; db < NDB; ++db)
#pragma unroll
        for (int r = 0; r < 16; ++r) o[db][r] = 0.f;
    const int kaddr = hi * 1024 + r32 * 16;
    const int vaddr = (4 * hi + ((lane & 15) >> 2)) * 64 + ((lane >> 4) & 1) * 32 + (lane & 3) * 8;
    auto tile_c = [&](int t) -> float { if (MODE != 1) return 0.f; const int k0 = t * 64; return (k0 + 63 - qpos <= -128) ? cL : ((k0 - (qpos + 31) >= 128) ? cR : 0.f); };
    auto tile_near = [&](int t) -> bool { if (MODE == 0 || MODE == 3) return false; if (MODE == 2) return true; const int k0 = t * 64; return !(k0 + 63 - qpos <= -128) && !(k0 - (qpos + 31) >= 128); };
    float ccur = tile_c(kt0);
    f32x16 negm;
#pragma unroll
    for (int r = 0; r < 16; ++r) negm[r] = ccur;
    asm volatile("" : "+v"(negm));
    bf16x8 pf[4]; f32x16 s0, s1;
    bf16x8 kf[8];
#define LOAD_KF(slot) do { const LAS unsigned char* Kb_ = lds + K_OFF + (slot) * 8192 + kaddr; _Pragma("unroll") for (int d0_ = 0; d0_ < 4; ++d0_) { kf[2 * d0_] = *(const LAS bf16x8*)(Kb_ + d0_ * 2048); kf[2 * d0_ + 1] = *(const LAS bf16x8*)(Kb_ + d0_ * 2048 + 512); } } while (0)
    LOAD_KF(0);
    if (grp == 1) ATT_BAR();
    for (int i = 0; i < nt; ++i) {
        const int t = kt0 + i;
        const int sk = i & 3, sv = (i + 3) & 3;
        const bool steady = (i + 3 < nt);
        __builtin_amdgcn_s_setprio(1);
        const bool dv = (i + 2 < nt);
        if (MODE == 3) { const f32x16 z = {0.f, 0.f, 0.f, 0.f, 0.f, 0.f, 0.f, 0.f, 0.f, 0.f, 0.f, 0.f, 0.f, 0.f, 0.f, 0.f};
            s0 = __builtin_amdgcn_mfma_f32_32x32x16_bf16(kf[0], qr[0], z, 0, 0, 0); s1 = __builtin_amdgcn_mfma_f32_32x32x16_bf16(kf[1], qr[0], z, 0, 0, 0); }
        else { s0 = __builtin_amdgcn_mfma_f32_32x32x16_bf16(kf[0], qr[0], negm, 0, 0, 0); s1 = __builtin_amdgcn_mfma_f32_32x32x16_bf16(kf[1], qr[0], negm, 0, 0, 0); }
        __builtin_amdgcn_sched_barrier(0);
        if (steady) DMA_K(t + 3, (i + 3) & 3);
        __builtin_amdgcn_sched_barrier(0);
        s0 = __builtin_amdgcn_mfma_f32_32x32x16_bf16(kf[2], qr[1], s0, 0, 0, 0); s1 = __builtin_amdgcn_mfma_f32_32x32x16_bf16(kf[3], qr[1], s1, 0, 0, 0);
        __builtin_amdgcn_sched_barrier(0);
        if (dv) glds16(vsrc[0] + (size_t)(t + 2) * 64 * PW, (unsigned)__builtin_amdgcn_readfirstlane(vdst[0] + ((i + 2) & 3) * 16384));
        __builtin_amdgcn_sched_barrier(0);
        s0 = __builtin_amdgcn_mfma_f32_32x32x16_bf16(kf[4], qr[2], s0, 0, 0, 0); s1 = __builtin_amdgcn_mfma_f32_32x32x16_bf16(kf[5], qr[2], s1, 0, 0, 0);
        __builtin_amdgcn_sched_barrier(0);
        if (NVP == 2) { if (dv) glds16(vsrc[NVP - 1] + (size_t)(t + 2) * 64 * PW, (unsigned)__builtin_amdgcn_readfirstlane(vdst[NVP - 1] + ((i + 2) & 3) * 16384)); }
        __builtin_amdgcn_sched_barrier(0);
        s0 = __builtin_amdgcn_mfma_f32_32x32x16_bf16(kf[6], qr[3], s0, 0, 0, 0); s1 = __builtin_amdgcn_mfma_f32_32x32x16_bf16(kf[7], qr[3], s1, 0, 0, 0);
        __builtin_amdgcn_sched_barrier(0);
        if (i > 0) pv_block<NDB>(lds + V_OFF + sv * 16384 + vaddr, pf, o);
        __builtin_amdgcn_s_setprio(0);
        if (i == 0) asm volatile("s_nop 15\n\ts_nop 15\n\ts_nop 15\n\ts_nop 15\n\ts_nop 15" ::: "memory");
        ATT_BAR_S(s0, s1);
        if (MODE == 1 || MODE == 2) {
            if (tile_near(t)) {
                const int rel0 = t * 64 - (qpos + r32) + 4 * hi;
#pragma unroll
                for (int r = 0; r < 16; ++r) {
                    const int rel = rel0 + (r & 3) + 8 * (r >> 2), rel1 = rel + 32;
                    const int i0 = min(max(rel, -128), 128) + 128, i1 = min(max(rel1, -128), 128) + 128;
                    s0[r] += lut[i0]; s1[r] += lut[i1];
                    if (MODE == 2) { if (rel < -128 || rel > 128) s0[r] = -__builtin_inff(); if (rel1 < -128 || rel1 > 128) s1[r] = -__builtin_inff(); }
                }
            }
        }
        if (i + 1 < nt) LOAD_KF((i + 1) & 3);
        __builtin_amdgcn_sched_barrier(0);
        float mx = 0.f;
        if (MODE != 3) {
            float mx2;
            mx = max3f(s0[0], s1[0], s0[1]); mx2 = max3f(s1[1], s0[2], s1[2]);
#pragma unroll
            for (int r = 3; r < 15; r += 2) { mx = max3f(mx, s0[r], s1[r]); mx2 = max3f(mx2, s0[r + 1], s1[r + 1]); }
            mx = max3f(mx, s0[15], s1[15]); mx = max3f(mx, mx2, mx2);
            mx = swapmax(mx);
        }
        bool changed = false;
        if (MODE == 3) {
        } else if (MODE == 2) {
            if (__any(mx > m + THR)) {
                const float mn = fmaxf(m, mx), a = __builtin_amdgcn_exp2f(m - mn);
                l *= a;
#pragma unroll
                for (int db = 0; db < NDB; ++db)
#pragma unroll
                    for (int r = 0; r < 16; ++r) o[db][r] *= a;
                m = mn;
            }
#pragma unroll
            for (int r = 0; r < 16; ++r) { s0[r] -= m; s1[r] -= m; }
        } else {
            if (i == 0) {
                m = mx; changed = true;
#pragma unroll
                for (int r = 0; r < 16; ++r) { s0[r] -= mx; s1[r] -= mx; }
            } else if (__any(mx > THR)) {
                const float dl = fmaxf(mx, 0.f), a = __builtin_amdgcn_exp2f(-dl);
                m += dl; l *= a; changed = true;
#pragma unroll
                for (int r = 0; r < 16; ++r) { s0[r] -= dl; s1[r] -= dl; }
#pragma unroll
                for (int db = 0; db < NDB; ++db)
#pragma unroll
                    for (int r = 0; r < 16; ++r) o[db][r] *= a;
            }
        }
        float ps = 0.f;
#pragma unroll
        for (int r = 0; r < 16; ++r) { s0[r] = __builtin_amdgcn_exp2f(s0[r]); s1[r] = __builtin_amdgcn_exp2f(s1[r]); ps += s0[r] + s1[r]; }
        l += ps;
        { u32x4 w;
          w.x = cvtpk(s0[0], s0[1]); w.y = cvtpk(s0[2], s0[3]); w.z = cvtpk(s0[4], s0[5]); w.w = cvtpk(s0[6], s0[7]); pf[0] = __builtin_bit_cast(bf16x8, w);
          w.x = cvtpk(s0[8], s0[9]); w.y = cvtpk(s0[10], s0[11]); w.z = cvtpk(s0[12], s0[13]); w.w = cvtpk(s0[14], s0[15]); pf[1] = __builtin_bit_cast(bf16x8, w);
          w.x = cvtpk(s1[0], s1[1]); w.y = cvtpk(s1[2], s1[3]); w.z = cvtpk(s1[4], s1[5]); w.w = cvtpk(s1[6], s1[7]); pf[2] = __builtin_bit_cast(bf16x8, w);
          w.x = cvtpk(s1[8], s1[9]); w.y = cvtpk(s1[10], s1[11]); w.z = cvtpk(s1[12], s1[13]); w.w = cvtpk(s1[14], s1[15]); pf[3] = __builtin_bit_cast(bf16x8, w); }
        if (MODE != 2 && MODE != 3) {
            const float cnext = tile_c(t + 1);
            if (changed || cnext != ccur) { ccur = cnext; const float v = ccur - m;
#pragma unroll
                for (int r = 0; r < 16; ++r) negm[r] = v;
                asm volatile("" : "+v"(negm)); }
        }
        if (steady) { if (NVP == 1) asm volatile("s_waitcnt vmcnt(2)" ::: "memory"); else asm volatile("s_waitcnt vmcnt(3)" ::: "memory"); }
        else asm volatile("s_waitcnt vmcnt(0)" ::: "memory");
        ATT_BAR_P(pf);
    }
    pv_block<NDB>(lds + V_OFF + ((nt + 3) & 3) * 16384 + vaddr, pf, o);
    if (grp == 0) ATT_BAR();
    __syncthreads();
#undef DMA_K
#undef DMA_V
#undef LOAD_KF
    m_io = m; l_io = l;
}

__device__ __forceinline__ void load_q(bf16x8 (&qr)[4], const bf16_t* Qrow, int hi) {
#pragma unroll
    for (int d0 = 0; d0 < 4; ++d0) qr[d0] = *(const bf16x8*)(Qrow + d0 * 16 + hi * 8);
}
template <int NDB>
__device__ __forceinline__ void store_o(bf16_t* Orow, const f32x16 (&o)[NDB], int hi) {
#pragma unroll
    for (int db = 0; db < NDB; ++db)
#pragma unroll
        for (int gp = 0; gp < 2; ++gp) {
            const unsigned x0 = cvtpk(o[db][8 * gp], o[db][8 * gp + 1]), x1 = cvtpk(o[db][8 * gp + 2], o[db][8 * gp + 3]);
            const unsigned y0 = cvtpk(o[db][8 * gp + 4], o[db][8 * gp + 5]), y1 = cvtpk(o[db][8 * gp + 6], o[db][8 * gp + 7]);
            const auto r0 = __builtin_amdgcn_permlane32_swap(x0, y0, false, false), r1 = __builtin_amdgcn_permlane32_swap(x1, y1, false, false);
            u32x4 w; w.x = r0[0]; w.y = r1[0]; w.z = r0[1]; w.w = r1[1];
            *(u32x4*)(Orow + 32 * db + 16 * gp + 8 * hi) = w; }
}

__device__ __forceinline__ void load_q_a(bf16x8 (&qr)[4], const float* qsrc, const float* gq, int tpos, int hi) {
    float x[4][8];
#pragma unroll
    for (int d0 = 0; d0 < 4; ++d0) { const f32x4 a = *(const f32x4*)(qsrc + 16 * d0 + 8 * hi), b = *(const f32x4*)(qsrc + 16 * d0 + 8 * hi + 4);
#pragma unroll
        for (int e = 0; e < 4; ++e) { x[d0][e] = a[e]; x[d0][4 + e] = b[e]; } }
    float ss = 0.f;
#pragma unroll
    for (int d0 = 0; d0 < 4; ++d0)
#pragma unroll
        for (int j = 0; j < 8; ++j) ss += x[d0][j] * x[d0][j];
    ss = swapsum(ss);
    const float r = __builtin_amdgcn_rsqf(ss * (1.0f / 64.0f) + EPS);
#pragma unroll
    for (int hf = 0; hf < 2; ++hf) {
        const float pos = (float)(hf ? (tpos & 63) : (tpos >> 6));
        u32x4 w1, w2;
#pragma unroll
        for (int j = 0; j < 8; j += 2) {
            float y1[2], y2[2];
#pragma unroll
            for (int e = 0; e < 2; ++e) { const int i = 8 * hi + j + e;
                const float freq = __builtin_amdgcn_exp2f(-(float)i * (13.287712379549449f / 16.0f));
                float rev = pos * freq * 0.15915494309189535f; rev -= floorf(rev);
                const float sn = __builtin_amdgcn_sinf(rev), cs = __builtin_amdgcn_cosf(rev);
                const float a1 = x[2 * hf][j + e] * r * gq[32 * hf + i], a2 = x[2 * hf + 1][j + e] * r * gq[32 * hf + 16 + i];
                y1[e] = (a1 * cs - a2 * sn) * C2; y2[e] = (a1 * sn + a2 * cs) * C2; }
            w1[j >> 1] = cvtpk(y1[0], y1[1]); w2[j >> 1] = cvtpk(y2[0], y2[1]);
        }
        qr[2 * hf] = __builtin_bit_cast(bf16x8, w1); qr[2 * hf + 1] = __builtin_bit_cast(bf16x8, w2);
    }
}
__device__ __forceinline__ void unit_a(LAS unsigned char* lds, bf16_t* P, const float* QKs, const float* gq, int h, int qb, bool bounded) {
    const int tid = opaque_tid(), lane = tid & 63, wid = __builtin_amdgcn_readfirstlane(tid >> 6), r32 = lane & 31, hi = lane >> 5;
    const int qpos = qb * 256 + wid * 32;
    bf16_t* Qrow = P + (size_t)(qpos + r32) * PW + h * 64;
    bf16x8 qr[4]; load_q_a(qr, QKs + (size_t)(qpos + r32) * QKW + h * 64, gq, qpos + r32, hi);
    f32x16 o[2]; float m, l;
    if (bounded) attn_pass<64, 3>(lds, P + 512 + (h >> 2) * 64, P + 640 + (h >> 2) * 64, 0, SEQ / 64, qr, o, m, l, qpos, 0.f, 0.f);
    else attn_pass<64, 0>(lds, P + 512 + (h >> 2) * 64, P + 640 + (h >> 2) * 64, 0, SEQ / 64, qr, o, m, l, qpos, 0.f, 0.f);
    l = swapsum(l); const float inv = 1.0f / l;
#pragma unroll
    for (int db = 0; db < 2; ++db)
#pragma unroll
        for (int r = 0; r < 16; ++r) o[db][r] *= inv;
    store_o<2>(Qrow, o, hi);
}
__device__ __forceinline__ void unit_b(LAS unsigned char* lds, bf16_t* P, int h, int qb, const float* lutg, float sink_l2) {
    const int tid = opaque_tid(), lane = tid & 63, wid = __builtin_amdgcn_readfirstlane(tid >> 6), r32 = lane & 31, hi = lane >> 5;
    LAS float* lut = (LAS float*)(lds + LUT_OFF);
    if (tid < 257) lut[tid] = lutg[h * 257 + tid];
    const int q0 = qb * 256, qpos = q0 + wid * 32;
    bf16_t* Qrow = P + (size_t)(qpos + r32) * PW + 768 + h * 64;
    bf16x8 qr[4]; load_q(qr, Qrow, hi);
    int kt0 = (q0 - 128) / 64, kt1 = (q0 + 384) / 64; if (q0 < 128) kt0 = 0; if (kt1 > SEQ / 64) kt1 = SEQ / 64;
    f32x16 o[2]; float m, l;
    attn_pass<64, 2>(lds, P + 1280 + (h >> 2) * 64, P + 1408 + (h >> 2) * 64, kt0, kt1, qr, o, m, l, qpos, 0.f, 0.f);
    l = swapsum(l);
    const float mf = fmaxf(m, sink_l2), a = __builtin_amdgcn_exp2f(m - mf);
    l = l * a + __builtin_amdgcn_exp2f(sink_l2 - mf);
    const float inv = a / l;
#pragma unroll
    for (int db = 0; db < 2; ++db)
#pragma unroll
        for (int r = 0; r < 16; ++r) o[db][r] *= inv;
    store_o<2>(Qrow, o, hi);
}
__device__ __forceinline__ void unit_c(LAS unsigned char* lds, bf16_t* P, int h, int qb, const float* lutg, float lam, float one_m_li, const float* subln, float* stash) {
    const int tid = opaque_tid(), lane = tid & 63, wid = __builtin_amdgcn_readfirstlane(tid >> 6), r32 = lane & 31, hi = lane >> 5;
    LAS float* lut = (LAS float*)(lds + LUT_OFF);
    if (tid < 257) lut[tid] = lutg[(8 + h) * 257 + tid];
    const float cL = lutg[(8 + h) * 257 + 0], cR = lutg[(8 + h) * 257 + 256];
    const int qpos = qb * 256 + wid * 32;
    bf16_t* Qrow = P + (size_t)(qpos + r32) * PW + 1536 + h * 128;
    const bf16_t* Kp = P + 2048 + (h >> 1) * 128; const bf16_t* Vp = P + 2304 + (h >> 1) * 128;
    f32x16 o[4]; float m, l;
    { bf16x8 qr[4]; load_q(qr, Qrow, hi);
      attn_pass<128, 1>(lds, Kp, Vp, 0, SEQ / 64, qr, o, m, l, qpos, cL, cR); }
    f32x4* st = (f32x4*)(stash + (size_t)tid * 64);
    l = swapsum(l); { const float inv = 1.0f / l;
#pragma unroll
    for (int db = 0; db < 4; ++db)
#pragma unroll
        for (int g4 = 0; g4 < 4; ++g4) st[db * 4 + g4] = (f32x4){o[db][4 * g4] * inv, o[db][4 * g4 + 1] * inv, o[db][4 * g4 + 2] * inv, o[db][4 * g4 + 3] * inv}; }
    asm volatile("" ::: "memory");
    { bf16x8 qr[4]; load_q(qr, Qrow + 64, hi);
      attn_pass<128, 1>(lds, Kp + 64, Vp, 0, SEQ / 64, qr, o, m, l, qpos, cL, cR); }
    l = swapsum(l); const float inv2 = lam / l; float ss = 0.f;
#pragma unroll
    for (int db = 0; db < 4; ++db)
#pragma unroll
        for (int g4 = 0; g4 < 4; ++g4) { const f32x4 s4 = st[db * 4 + g4];
#pragma unroll
            for (int e = 0; e < 4; ++e) { const float v = s4[e] - o[db][4 * g4 + e] * inv2; o[db][4 * g4 + e] = v; ss += v * v; } }
    ss = swapsum(ss);
    const float rs = __builtin_amdgcn_rsqf(ss * (1.0f / 128.0f) + EPS) * one_m_li;
#pragma unroll
    for (int db = 0; db < 4; ++db)
#pragma unroll
        for (int r = 0; r < 16; ++r) o[db][r] *= rs * subln[32 * db + crow(r, hi)];
    store_o<4>(Qrow, o, hi);
}
}
__device__ __forceinline__ void tr_item(const float* __restrict__ W, int ldn, int k0, int nsrc0, bf16_t* WT, int ldk, int ndst0, int nrep, int repstride, const float* gain, LAS float* scr, int lane) {
    f32x4 wv[8];
#pragma unroll
    for (int i = 0; i < 8; ++i) wv[i] = *(const f32x4*)(W + (size_t)(k0 + 8 * i + (lane >> 3)) * ldn + nsrc0 + (lane & 7) * 4);
#pragma unroll
    for (int i = 0; i < 8; ++i) { const int kk = 8 * i + (lane >> 3); const float gsc = gain ? gain[k0 + kk] : 1.0f; LAS float* d = scr + kk * 33 + (lane & 7) * 4;
        d[0] = wv[i][0] * gsc; d[1] = wv[i][1] * gsc; d[2] = wv[i][2] * gsc; d[3] = wv[i][3] * gsc; }
    LDS_WAIT();
    const int c = lane & 7;
#pragma unroll
    for (int j = 0; j < 4; ++j) { const int n = (lane >> 3) + 8 * j; const LAS float* s = scr + (8 * c) * 33 + n;
        v4u o; o.x = pk2(s[0 * 33], s[1 * 33]); o.y = pk2(s[2 * 33], s[3 * 33]); o.z = pk2(s[4 * 33], s[5 * 33]); o.w = pk2(s[6 * 33], s[7 * 33]);
        for (int rep = 0; rep < nrep; ++rep) *(v4u*)(WT + (size_t)(ndst0 + n) * ldk + rep * repstride + k0 + 8 * c) = o; }
    LDS_WAIT();
}
__device__ __forceinline__ int t5_bucket(int rel) {
    const int n = rel < 0 ? -rel : rel; int b;
    if (n < 8) b = n; else { int k = 0; while (k < 8 && (64 << (k + 1)) <= n * n) ++k; b = 8 + k; if (b > 15) b = 15; }
    return (rel > 0 ? 16 : 0) + b;
}

#define XB_TMO      128
#define XB_XCNT(j)  (256  + 64 * (j))
#define XB_XSUB(j)  (1280 + 64 * (j))
#define XB_XGEN(j)  (2304 + 64 * (j))
#define XB_TOP      3328
#define XB_TOPGEN   3392
#define XCD_BAR_WORDS 3456
#define XB_SPIN_CAP (1u << 18)

__device__ __forceinline__ unsigned xb_ld(unsigned* p)              { return __hip_atomic_load(p, __ATOMIC_RELAXED, __HIP_MEMORY_SCOPE_AGENT); }
__device__ __forceinline__ unsigned xb_add(unsigned* p, unsigned v) { return __hip_atomic_fetch_add(p, v, __ATOMIC_RELAXED, __HIP_MEMORY_SCOPE_AGENT); }
__device__ __forceinline__ unsigned xb_xcc_id() { return (unsigned)__builtin_amdgcn_s_getreg((3 << 11) | 20) & 0xFu; }
#define XB_SPIN(cond, bar) do { unsigned _sp = 0; while (cond) { __builtin_amdgcn_s_sleep(1); \
    if ((++_sp & 255u) == 0u) { if (xb_ld(&(bar)[XB_TMO])) break; if (_sp > XB_SPIN_CAP) { atomicAdd(&(bar)[XB_TMO], 1u); break; } } } } while (0)

struct XcdBarrier {
    unsigned* bar; unsigned x;
    volatile LAS unsigned* st;
};

__device__ __forceinline__ XcdBarrier xcd_barrier_post(unsigned* bar, volatile LAS unsigned* st) {
    XcdBarrier b; b.bar = bar; b.x = xb_xcc_id(); b.st = st;
    if (threadIdx.x == 0) (void)xb_add(&bar[XB_XCNT(b.x)], 1u);
    return b;
}
__device__ __forceinline__ void xcd_barrier_complete(unsigned* bar, unsigned x, unsigned& nloc, unsigned& nx) {
    const unsigned G = gridDim.x * gridDim.y * gridDim.z;
    unsigned sum, cnt, mine, sp = 0u;
    for (;;) {
        sum = 0u; cnt = 0u; mine = 0u;
#pragma unroll
        for (unsigned j = 0; j < 16; ++j) { const unsigned c = xb_ld(&bar[XB_XCNT(j)]); sum += c; cnt += (c > 0u) ? 1u : 0u; mine = (j == x) ? c : mine; }
        if (sum == G) break;
        __builtin_amdgcn_s_sleep(1);
        if ((++sp & 255u) == 0u) { if (xb_ld(&bar[XB_TMO])) break; if (sp > XB_SPIN_CAP) { atomicAdd(&bar[XB_TMO], 1u); break; } }
    }
    nloc = mine > 0u ? mine : 1u; nx = cnt > 0u ? cnt : 1u;
}

__device__ __forceinline__ void xcd_barrier(const XcdBarrier& b) {
    asm volatile("s_waitcnt vmcnt(0)" ::: "memory");
    __syncthreads();
    if (threadIdx.x == 0) {
        unsigned* bar = b.bar;
        __builtin_amdgcn_s_waitcnt(0);
        unsigned nloc = b.st[0], nx = b.st[1];
        if (nloc == 0u) { xcd_barrier_complete(bar, b.x, nloc, nx); b.st[0] = nloc; b.st[1] = nx; }
        const unsigned old = xb_add(&bar[XB_XSUB(b.x)], 1u);
        const unsigned gen = old / nloc;
        if (old + 1u == (gen + 1u) * nloc) {
            __builtin_amdgcn_fence(__ATOMIC_RELEASE, "agent");
            asm volatile("s_waitcnt vmcnt(0)" ::: "memory");
            const unsigned og = xb_add(&bar[XB_TOP], 1u);
            const unsigned tg = og / nx;
            if (og + 1u == (tg + 1u) * nx) xb_add(&bar[XB_TOPGEN], 1u);
            else XB_SPIN(xb_ld(&bar[XB_TOPGEN]) == tg, bar);
            __builtin_amdgcn_fence(__ATOMIC_ACQUIRE, "agent");
            xb_add(&bar[XB_XGEN(b.x)], 1u);
            asm volatile("s_waitcnt vmcnt(0)" ::: "memory");
        } else {
            XB_SPIN(xb_ld(&bar[XB_XGEN(b.x)]) == gen, bar);
            __builtin_amdgcn_fence(__ATOMIC_ACQUIRE, "agent");
            asm volatile("s_waitcnt vmcnt(0)" ::: "memory");
        }
    }
    __syncthreads();
}

struct Args { const float* in[21]; float* out; unsigned char* ws; };
__global__ void __launch_bounds__(512, 2) fwd_megakernel(Args a) {
    extern __shared__ __attribute__((aligned(16))) unsigned char lds_raw[];
    LAS unsigned char* lds = (LAS unsigned char*)lds_raw;
    cg::grid_group grid = cg::this_grid();
    const int tid = opaque_tid(), lane = tid & 63, wave = __builtin_amdgcn_readfirstlane(tid >> 6);
    const int G = gridDim.x, bx = blockIdx.x;
    const int vcu = (G % 8 == 0) ? (bx % 8) * (G / 8) + bx / 8 : bx;
    const int gw = vcu * 8 + wave, NGW = G * 8;
    unsigned char* ws = a.ws;
    float* ssb = (float*)(ws + WS_SS);
    float* lamb = (float*)(ws + WS_LAM);
    float* lutg = (float*)(ws + WS_LUT);
    bf16_t* XB = (bf16_t*)(ws + WS_XB);
    bf16_t* ACT = (bf16_t*)(ws + WS_R2);
    bf16_t* GT = (bf16_t*)(ws + WS_R2);
    bf16_t* P = (bf16_t*)(ws + WS_P);
    float* QK = (float*)(ws + WS_QK);
    float* stash = (float*)(ws + WS_O1) + (size_t)bx * 64 * 512;
    float* X = a.out;

    {
        const unsigned simd = (unsigned)__builtin_amdgcn_s_getreg(((2 - 1) << 11) | (4 << 6) | 4);
        volatile LAS unsigned* sw = (volatile LAS unsigned*)(lds + 131072 + 64);
        sw[wave] = simd;
        __syncthreads();
        unsigned rank = 0;
        for (int w = 0; w < 8; ++w) if (w < wave && sw[w] == simd) ++rank;
        __syncthreads();
        sw[8 + wave] = rank & 1u;
        __syncthreads();
    }
    { volatile LAS unsigned* st0 = (volatile LAS unsigned*)(lds + 131072 + 128); if (tid < 2) st0[tid] = 0u; }
    __syncthreads();
    const XcdBarrier gbar = xcd_barrier_post((unsigned*)(a.ws + WS_BAR), (volatile LAS unsigned*)(lds + 131072 + 128));
    {
        LAS float* scr = (LAS float*)(lds + wave * 16384);
        constexpr int I_IN = 16 * 176, I_OUT = 44 * 32, I_WB = 8 * 32, I_WO = 16 * 32, I_LAYER = 3 * I_IN + 2 * I_OUT + 3 * I_WB + I_WO;
        for (int it = gw; it < 2 * I_LAYER; it += NGW) {
            const int l = it / I_LAYER; int r = it - l * I_LAYER;
            unsigned char* wl = ws + WS_W + (size_t)l * W_LAYER;
            if (r < I_IN || (r >= I_IN + I_OUT + I_IN + 3 * I_WB + I_WO && r < I_IN + I_OUT + I_IN + 3 * I_WB + I_WO + I_IN)) {
                const bool second = r >= I_IN; if (second) r -= I_IN + I_OUT + I_IN + 3 * I_WB + I_WO;
                const int kb = r / 176, nb = r % 176, n0 = 32 * nb, pn = n0 >> 8, bj = (n0 >> 7) & 1, j0 = n0 & 127;
                tr_item(a.in[second ? 18 : 3] + (size_t)l * 1024 * 5632, 5632, 64 * kb, bj * 2816 + 128 * pn + j0, (bf16_t*)(wl + (second ? W_2IN : W_1IN)), 1024, n0, 1, 0, a.in[second ? 17 : 2] + l * 1024, scr, lane);
                continue;
            }
            r -= I_IN;
            if (r < I_OUT) { const int kb = r / 32, nb = r % 32; tr_item(a.in[4] + (size_t)l * 2816 * 1024, 1024, 64 * kb, 32 * nb, (bf16_t*)(wl + W_1OUT), 2816, 32 * nb, 1, 0, nullptr, scr, lane); continue; }
            r -= I_OUT;
            if (r < I_IN) { const int kb = r / 176, nb = r % 176; tr_item(a.in[6] + (size_t)l * 1024 * 5632, 5632, 64 * kb, 32 * nb, (bf16_t*)(wl + W_IN), 1024, 32 * nb, 1, 0, a.in[5] + l * 1024, scr, lane); continue; }
            r -= I_IN;
            if (r < 3 * I_WB) { const int br = r / I_WB; r -= br * I_WB; const int kb = r / 32, nb = r % 32;
                tr_item(a.in[15] + (size_t)(l * 3 + br) * 512 * 1024, 1024, 64 * kb, 32 * nb, (bf16_t*)(wl + W_B), 512, br * 1024 + 32 * nb, 1, 0, nullptr, scr, lane); continue; }
            r -= 3 * I_WB;
            if (r < I_WO) { const int kb = r / 32, nb = r % 32; tr_item(a.in[16] + (size_t)l * 1024 * 1024, 1024, 64 * kb, 32 * nb, (bf16_t*)(wl + W_O3), 3072, 32 * nb, 3, 1024, nullptr, scr, lane); continue; }
            r -= I_WO + I_IN;
            { const int kb = r / 32, nb = r % 32; tr_item(a.in[19] + (size_t)l * 2816 * 1024, 1024, 64 * kb, 32 * nb, (bf16_t*)(wl + W_2OUT), 2816, 32 * nb, 1, 0, nullptr, scr, lane); }
        }
        for (int row = gw; row < T; row += NGW) {
            const f32x4* xr = (const f32x4*)(a.in[0] + (size_t)row * D) + lane; float s = 0.f;
            unsigned long long* o8 = (unsigned long long*)(XB + (size_t)row * D) + lane;
#pragma unroll
            for (int j = 0; j < 4; ++j) { const f32x4 v = xr[64 * j]; s += (v.x * v.x + v.y * v.y) + (v.z * v.z + v.w * v.w);
                o8[64 * j] = (unsigned long long)pk2(v.x, v.y) | ((unsigned long long)pk2(v.z, v.w) << 32); }
            s = wave_sum(s);
            if (lane == 0) ssb[row] = s;
        }
        for (int i = bx * 512 + tid; i < 6 * T; i += G * 512) ssb[T + i] = 0.f;
        if (bx == 0) {
            for (int i = tid; i < 12 * 257; i += 512) { const int hh = i / 257, rel = i % 257 - 128; lutg[i] = a.in[1][t5_bucket(rel) * 12 + hh] * LOG2E; }
            if (wave < 2) { const int l = wave;
                const float s1 = wave_sum(a.in[10][l * 64 + lane] * a.in[11][l * 64 + lane]), s2 = wave_sum(a.in[12][l * 64 + lane] * a.in[13][l * 64 + lane]);
                const float li = 0.8f - 0.6f * expf(-0.3f * (float)l);
                if (lane == 0) lamb[l] = expf(s1) - expf(s2) + li; }
        }
    }
    grid.sync();

    for (int l = 0; l < 2; ++l) {
        unsigned char* wl = ws + WS_W + (size_t)l * W_LAYER;
        const float lambda_init = 0.8f - 0.6f * expf(-0.3f * (float)l);
        for (int f = 0; f < 2; ++f) {
            {
                pg8::Gemm g{XB, (const bf16_t*)(wl + (f ? W_2IN : W_1IN)), T, NIN, D, D, D, 1 << 20, 0};
                pg8::StaticOrder S; S.init(T, NIN, G, bx);
                pg8::EpiSwiGLU E{ACT, ssb + (size_t)(3 * l + 2 * f) * T, DFF};
                pg8::gemm_phase<pg8::EpiSwiGLU, pg8::StaticOrder, true, true>(lds, g, S, E);
            }
            xcd_barrier(gbar);
            {
                pg8::Gemm g{ACT, (const bf16_t*)(wl + (f ? W_2OUT : W_1OUT)), T, D, DFF, DFF, DFF, 1 << 20, 0};
                pg8::StaticOrder S; S.init(T, D, G, bx);
                pg8::EpiResid E{(l == 0 && f == 0) ? a.in[0] : (const float*)X, X, (l == 1 && f == 1) ? (bf16_t*)nullptr : XB, ssb + (size_t)(3 * l + 2 * f + 1) * T, 0.5f};
                pg8::gemm_phase<pg8::EpiResid, pg8::StaticOrder, true, true>(lds, g, S, E);
            }
            xcd_barrier(gbar);
            if (f == 1) break;
            for (int b = 0; b < NBATCH; ++b) {
                const size_t rb = (size_t)b * SEQ;
                {
                    pg8::Gemm g{XB + rb * D, (const bf16_t*)(wl + W_IN), SEQ, NIN, D, D, D, 1 << 20, 0};
                    pg8::StaticOrder S; S.init(SEQ, NIN, G, bx);
                    pg8::EpiProj E{P, QK, GT, ssb + (size_t)(3 * l + 1) * T + rb};
                    pg8::gemm_phase<pg8::EpiProj, pg8::StaticOrder, true, true>(lds, g, S, E);
                }
                xcd_barrier(gbar);
                {
                    const int lane = opaque_tid() & 63; const int p = lane & 31, half = p >> 4, i = p & 15, hd = lane >> 5;
                    const float freq = __builtin_amdgcn_exp2f(-(float)i * (13.287712379549449f / 16.0f));
                    const float gk1 = a.in[8][l * 64 + half * 32 + i], gk2 = a.in[8][l * 64 + half * 32 + 16 + i];
                    LAS bf16_t* stg = (LAS bf16_t*)(lds + wave * 8192);
                    for (int t0 = gw; t0 < SEQ; t0 += NGW * 4) {
                        float x1[4], x2[4];
#pragma unroll
                        for (int k = 0; k < 4; ++k) { const float* src = QK + (size_t)(t0 + k * NGW) * QKW + 512 + hd * 64 + half * 32 + i; x1[k] = src[0]; x2[k] = src[16]; }
#pragma unroll
                        for (int k = 0; k < 4; ++k) { const int tl = t0 + k * NGW;
                            const float pos = (float)(half ? (tl & 63) : (tl >> 6));
                            float rev = pos * freq * 0.15915494309189535f; rev -= floorf(rev);
                            const float sn = __builtin_amdgcn_sinf(rev), cs = __builtin_amdgcn_cosf(rev);
                            float a1 = x1[k], a2 = x2[k]; float s = a1 * a1 + a2 * a2;
#pragma unroll
                            for (int o = 1; o < 32; o <<= 1) s += __shfl_xor(s, o);
                            const float r = __builtin_amdgcn_rsqf(s * (1.0f / 64.0f) + EPS);
                            a1 *= r * gk1; a2 *= r * gk2;
                            stg[k * 128 + hd * 64 + half * 32 + i] = (bf16_t)f2bf(a1 * cs - a2 * sn); stg[k * 128 + hd * 64 + half * 32 + i + 16] = (bf16_t)f2bf(a1 * sn + a2 * cs); }
                        LDS_WAIT();
#pragma unroll
                        for (int k = 0; k < 4; ++k) if (lane < 16) *(v4u*)(P + (size_t)(t0 + k * NGW) * PW + 512 + lane * 8) = *(const LAS v4u*)(stg + k * 128 + lane * 8);
                        LDS_WAIT();
                    }
                }
                xcd_barrier(gbar);
                {
                    const float lam = lamb[l];
                    for (int uc = vcu; uc < 256; uc += G) att::unit_c(lds, P, uc >> 6, uc & 63, lutg, lam, 1.0f - lambda_init, a.in[14] + l * 128, stash);

                    bool bounded; { float gq = 0.f, gk = 0.f; for (int e = 0; e < 64; ++e) { gq = fmaxf(gq, fabsf(a.in[7][l * 64 + e])); gk = fmaxf(gk, fabsf(a.in[8][l * 64 + e])); } bounded = (8.0f * gq * gk * LOG2E < 24.0f); }
                    for (int ua = vcu; ua < 512; ua += G) att::unit_a(lds, P, QK, a.in[7] + l * 64, ua >> 6, ua & 63, bounded);

                    for (int ub = vcu; ub < 512; ub += G) att::unit_b(lds, P, ub >> 6, ub & 63, lutg, a.in[9][l * 8 + (ub >> 6)] * LOG2E);
                }
                xcd_barrier(gbar);
                {
                    pg8::Gemm g{P, (const bf16_t*)(wl + W_B), SEQ, GW, 512, PW, 512, 4, 768};
                    pg8::BranchOrder S{G, bx};
                    pg8::EpiGateSum E{GT, (bf16_t*)(ws + WS_QK)};
                    pg8::gemm_phase<pg8::EpiGateSum, pg8::BranchOrder, true, true>(lds, g, S, E);
                }
                xcd_barrier(gbar);
                {
                    pg8::Gemm g{(const bf16_t*)(ws + WS_QK), (const bf16_t*)(wl + W_O3), SEQ, D, D, D, GW, 1 << 20, 0};
                    pg8::StaticOrder S; S.init(SEQ, D, G, bx);
                    pg8::EpiResid E{X + rb * D, X + rb * D, XB + rb * D, ssb + (size_t)(3 * l + 2) * T + rb, 1.0f};
                    pg8::gemm_phase<pg8::EpiResid, pg8::StaticOrder, true, true>(lds, g, S, E);
                }
                xcd_barrier(gbar);
            }
        }
    }
    const int lane_f = opaque_tid() & 63;
    for (int row = gw; row < T; row += NGW) {
        const int lane = lane_f;
        const float rs = __builtin_amdgcn_rsqf(ssb[(size_t)6 * T + row] * (1.0f / 1024.0f) + EPS);
        f32x4* xr = (f32x4*)(X + (size_t)row * D) + lane; const f32x4* gr = (const f32x4*)a.in[20] + lane;
#pragma unroll
        for (int j = 0; j < 4; ++j) { const f32x4 v = xr[64 * j], g = gr[64 * j]; f32x4 ov = v * rs * g;
            xr[64 * j] = ov; }
    }
}

extern "C" void kernel_launch(void* const* d_in, const int* in_sizes, int n_in, void* d_out, int out_size, void* d_ws, size_t ws_size, hipStream_t stream) {
    static int grid = 0;
    if (grid == 0) {
        if (n_in != 21 || out_size != T * D || ws_size < WS_END) { fprintf(stderr, "kernel_launch: unexpected shapes (n_in %d out %d ws %zu)\n", n_in, out_size, ws_size); grid = -1; return; }
        int dev = 0, cus = 0;
        if (hipGetDevice(&dev) != hipSuccess || hipDeviceGetAttribute(&cus, hipDeviceAttributeMultiprocessorCount, dev) != hipSuccess) { grid = -1; return; }
        if (hipFuncSetAttribute((const void*)fwd_megakernel, hipFuncAttributeMaxDynamicSharedMemorySize, LDS_BYTES) != hipSuccess) { fprintf(stderr, "kernel_launch: hipFuncSetAttribute failed\n"); grid = -1; return; }
        int per_cu = 0;
        if (hipOccupancyMaxActiveBlocksPerMultiprocessor(&per_cu, (const void*)fwd_megakernel, 512, LDS_BYTES) != hipSuccess || per_cu < 1) fprintf(stderr, "kernel_launch: occupancy query says %d\n", per_cu);
        (void)hipGetLastError();
        grid = cus;
    }
    if (grid < 0) return;
    if (hipMemsetAsync((char*)d_ws + WS_BAR, 0, WS_BAR_BYTES, stream) != hipSuccess) { fprintf(stderr, "kernel_launch: hipMemsetAsync failed\n"); return; }
    Args a{};
    for (int i = 0; i < 21; ++i) a.in[i] = (const float*)d_in[i];
    a.out = (float*)d_out; a.ws = (unsigned char*)d_ws;
    void* args[] = {&a};
    hipError_t e = hipLaunchCooperativeKernel((const void*)fwd_megakernel, dim3(grid), dim3(512), args, LDS_BYTES, stream);
    if (e != hipSuccess) fprintf(stderr, "cooperative launch failed: %s (grid %d)\n", hipGetErrorString(e), grid);
}
```

```cpp
#include <hip/hip_runtime.h>
#include <hip/hip_cooperative_groups.h>
#include <cstdio>
#include <cstdint>
namespace cg = cooperative_groups;
__device__ __forceinline__ int opaque_tid() { int t = threadIdx.x; asm volatile("" : "+v"(t)); return t; }
namespace pg8 {
#define PG8_LAS __attribute__((address_space(3)))
typedef unsigned short bf16_t;
typedef short bf16x8 __attribute__((ext_vector_type(8)));
typedef float f32x4 __attribute__((ext_vector_type(4)));
typedef unsigned u32x4 __attribute__((ext_vector_type(4)));
constexpr int BM = 256, BK = 64, HALF = 128, HTB = HALF * BK * 2  , STAGE_BYTES = 8 * HTB, NXCD = 8, WGM = 8;

__host__ __device__ __forceinline__ int lds_byte(int r, int c) { const int st = (r >> 4) * 2 + (c >> 5), rr = r & 15, cc = c & 31, ob = rr * 64 + cc * 2; return st * 1024 + (ob ^ (((ob >> 9) & 1) << 5)); }
__host__ __device__ __forceinline__ void stage_rc(int b, int& R, int& C) { const int st = b / 1024, sb = b % 1024, swz = sb ^ (((sb >> 9) & 1) << 5); R = (st >> 1) * 16 + swz / 64; C = (st & 1) * 32 + (swz % 64) / 2; }
__host__ __device__ __forceinline__ int perm32(int rho) { const int n = rho >> 4, i = rho & 15; return 8 * (i >> 2) + 4 * n + (i & 3); }

struct Unit { int pm, pn; };
struct Gemm { const bf16_t* A; const bf16_t* Bt; int M, N, K; int lda, ldb; int agrp, astride; };

struct StaticOrder {
    int nM, nN, nwg, G, c;
    __host__ __device__ void init(int M, int N, int G_, int c_) { nM = M / BM; nN = N / BM; nwg = nM * nN; G = G_; c = c_; }
    __host__ __device__ bool next(int i, Unit& u) const {
        const long L = (long)i * G + c; if (L >= nwg) return false;
        int wgid = (int)L; { const int q = nwg / NXCD, r = nwg % NXCD, xcd = wgid % NXCD, off = wgid / NXCD; wgid = (xcd < r ? xcd * (q + 1) : r * (q + 1) + (xcd - r) * q) + off; }
        const int nig = WGM * nN, gid = wgid / nig, fm = gid * WGM, gsz = (nM - fm) < WGM ? (nM - fm) : WGM;
        u.pm = fm + ((wgid % nig) % gsz); u.pn = (wgid % nig) / gsz; return true;
    }
    __device__ __forceinline__ void a_ready(const Unit&) const {}
    __device__ __forceinline__ void done(const Unit&) const {}
};


__device__ __forceinline__ unsigned cvt_pk_bf16(float lo, float hi) { unsigned r; asm volatile("v_cvt_pk_bf16_f32 %0, %1, %2" : "=v"(r) : "v"(lo), "v"(hi)); return r; }
typedef float f32x2 __attribute__((ext_vector_type(2)));

typedef unsigned u32x2 __attribute__((ext_vector_type(2)));
constexpr float RMS_EPS = 1e-6f, K_LOG2E = 1.4426950408889634f, K_C2 = 0.125f * 1.4426950408889634f;
__device__ __forceinline__ float sigm(float v) { return __builtin_amdgcn_rcpf(1.0f + __builtin_amdgcn_exp2f(-v * K_LOG2E)); }
struct EpiSwiGLU {
    static constexpr bool PERM = true, AFTER_DRAIN = false;
    bf16_t* O; const float* ss; int ldo;
    __device__ __forceinline__ void operator()(const f32x4 (&acc)[2][2][4][2], const Unit& u, int wr, int wc, int fr, int fq) const {
        const int row0 = u.pm * BM + wr * 64 + fr, col0 = u.pn * HALF + wc * 32 + 8 * fq;
#pragma unroll
        for (int ai = 0; ai < 2; ++ai)
#pragma unroll
            for (int m = 0; m < 4; ++m) { const int row = row0 + ai * HALF + m * 16; const float rs = __builtin_amdgcn_rsqf(ss[row] * (1.0f / 1024.0f) + RMS_EPS);
                float o[8];
#pragma unroll
                for (int n = 0; n < 2; ++n)
#pragma unroll
                    for (int e = 0; e < 4; ++e) { const float g = acc[ai][0][m][n][e] * rs, uu = acc[ai][1][m][n][e] * rs; o[4 * n + e] = g * sigm(g) * uu; }
                u32x4 w; w.x = cvt_pk_bf16(o[0], o[1]); w.y = cvt_pk_bf16(o[2], o[3]); w.z = cvt_pk_bf16(o[4], o[5]); w.w = cvt_pk_bf16(o[6], o[7]);
                *(u32x4*)(O + (size_t)row * ldo + col0) = w; asm volatile("" ::: "memory"); }
    }
};
struct EpiResid {
    static constexpr bool PERM = true, AFTER_DRAIN = false;
    const float* xin; float* xout; bf16_t* xb; float* ssout; float scale;
    __device__ __forceinline__ void operator()(const f32x4 (&acc)[2][2][4][2], const Unit& u, int wr, int wc, int fr, int fq) const {
        const int row0 = u.pm * BM + wr * 64 + fr, col0 = u.pn * BM + wc * 32 + 8 * fq;
#pragma unroll
        for (int ai = 0; ai < 2; ++ai) {
            f32x4 pre[4][2][2];
#pragma unroll
            for (int m = 0; m < 4; ++m)
#pragma unroll
                for (int bj = 0; bj < 2; ++bj)
#pragma unroll
                    for (int n = 0; n < 2; ++n) pre[m][bj][n] = *(const f32x4*)(xin + (size_t)(row0 + ai * HALF + m * 16) * 1024 + col0 + bj * HALF + n * 4);
            asm volatile("" ::: "memory");
#pragma unroll
            for (int m = 0; m < 4; ++m) { const int row = row0 + ai * HALF + m * 16; float s = 0.f;
#pragma unroll
                for (int bj = 0; bj < 2; ++bj) { const size_t off = (size_t)row * 1024 + col0 + bj * HALF;
                    const f32x4 o0 = pre[m][bj][0] + acc[ai][bj][m][0] * scale, o1 = pre[m][bj][1] + acc[ai][bj][m][1] * scale;
                    *(f32x4*)(xout + off) = o0; *(f32x4*)(xout + off + 4) = o1;
                    if (xb) { u32x4 w; w.x = cvt_pk_bf16(o0[0], o0[1]); w.y = cvt_pk_bf16(o0[2], o0[3]); w.z = cvt_pk_bf16(o1[0], o1[1]); w.w = cvt_pk_bf16(o1[2], o1[3]); *(u32x4*)(xb + off) = w; }
                    s += ((o0[0] * o0[0] + o0[1] * o0[1]) + (o0[2] * o0[2] + o0[3] * o0[3])) + ((o1[0] * o1[0] + o1[1] * o1[1]) + (o1[2] * o1[2] + o1[3] * o1[3])); }
                s += __shfl_xor(s, 16); s += __shfl_xor(s, 32);
                if (fq == 0) atomicAdd(ssout + row, s); }
            asm volatile("" ::: "memory");
        }
    }
};
struct EpiProj {
    static constexpr bool PERM = true, AFTER_DRAIN = false;
    bf16_t* P; float* QK; bf16_t* GT; const float* ss;
    __device__ __forceinline__ void operator()(const f32x4 (&acc)[2][2][4][2], const Unit& u, int wr, int wc, int fr, int fq) const {
        const int row0 = u.pm * BM + wr * 64 + fr, cl = wc * 32 + 8 * fq, pn = u.pn;
#pragma unroll
        for (int ai = 0; ai < 2; ++ai)
#pragma unroll
            for (int m = 0; m < 4; ++m) { const int row = row0 + ai * HALF + m * 16; const float rs = __builtin_amdgcn_rsqf(ss[row] * (1.0f / 1024.0f) + RMS_EPS);
#pragma unroll
                for (int bj = 0; bj < 2; ++bj) { const int ct = pn * BM + bj * HALF; f32x4 v0 = acc[ai][bj][m][0] * rs, v1 = acc[ai][bj][m][1] * rs;
                    if (pn >= 10) {
#pragma unroll
                        for (int e = 0; e < 4; ++e) { v0[e] = sigm(v0[e]); v1[e] = sigm(v1[e]); }
                        u32x4 w; w.x = cvt_pk_bf16(v0[0], v0[1]); w.y = cvt_pk_bf16(v0[2], v0[3]); w.z = cvt_pk_bf16(v1[0], v1[1]); w.w = cvt_pk_bf16(v1[2], v1[3]);
                        *(u32x4*)(GT + (size_t)row * 3072 + (ct - 2560) + cl) = w;
                    } else if (ct < 640) {
                        float* q = QK + (size_t)row * 640 + ct + cl; *(f32x4*)q = v0; *(f32x4*)(q + 4) = v1;
                    } else {
                        const float sc = ((ct >= 768 && ct < 1280) || (ct >= 1536 && ct < 2048)) ? K_C2 : 1.0f; v0 = v0 * sc; v1 = v1 * sc;
                        u32x4 w; w.x = cvt_pk_bf16(v0[0], v0[1]); w.y = cvt_pk_bf16(v0[2], v0[3]); w.z = cvt_pk_bf16(v1[0], v1[1]); w.w = cvt_pk_bf16(v1[2], v1[3]);
                        *(u32x4*)(P + (size_t)row * 2560 + ct + cl) = w;
                    } } asm volatile("" ::: "memory"); }
    }
};
struct EpiGate {
    static constexpr bool PERM = true, AFTER_DRAIN = false;
    bf16_t* GT;
    __device__ __forceinline__ void operator()(const f32x4 (&acc)[2][2][4][2], const Unit& u, int wr, int wc, int fr, int fq) const {
        const int row0 = u.pm * BM + wr * 64 + fr, cl = u.pn * BM + wc * 32 + 8 * fq;
#pragma unroll
        for (int ai = 0; ai < 2; ++ai)
#pragma unroll
            for (int m = 0; m < 4; ++m) { const int row = row0 + ai * HALF + m * 16;
#pragma unroll
                for (int bj = 0; bj < 2; ++bj) { bf16_t* p = GT + (size_t)row * 3072 + cl + bj * HALF; const u32x4 gv = *(const u32x4*)p;
                    const f32x4 v0 = acc[ai][bj][m][0], v1 = acc[ai][bj][m][1]; u32x4 w;
                    w.x = cvt_pk_bf16(v0[0] * __uint_as_float(gv.x << 16), v0[1] * __uint_as_float(gv.x & 0xffff0000u));
                    w.y = cvt_pk_bf16(v0[2] * __uint_as_float(gv.y << 16), v0[3] * __uint_as_float(gv.y & 0xffff0000u));
                    w.z = cvt_pk_bf16(v1[0] * __uint_as_float(gv.z << 16), v1[1] * __uint_as_float(gv.z & 0xffff0000u));
                    w.w = cvt_pk_bf16(v1[2] * __uint_as_float(gv.w << 16), v1[3] * __uint_as_float(gv.w & 0xffff0000u));
                    *(u32x4*)p = w; } asm volatile("" ::: "memory"); }
    }
};
struct BranchOrder {
    int G, c;
    __device__ __forceinline__ bool next(int i, Unit& u) const { const int tile = c + (i / 3) * G; if (tile >= 256) return false; u.pm = tile >> 2; u.pn = 4 * (i % 3) + (tile & 3); return true; }
    __device__ __forceinline__ void a_ready(const Unit&) const {}
    __device__ __forceinline__ void done(const Unit&) const {}
};
struct EpiGateSum {
    static constexpr bool PERM = true, AFTER_DRAIN = false;
    const bf16_t* GT; bf16_t* MB;
    __device__ __forceinline__ void operator()(const f32x4 (&acc)[2][2][4][2], const Unit& u, int wr, int wc, int fr, int fq) const {
        const int row0 = u.pm * BM + wr * 64 + fr, cg = u.pn * BM + wc * 32 + 8 * fq, cm = (u.pn & 3) * BM + wc * 32 + 8 * fq, br = u.pn >> 2;
#pragma unroll
        for (int ai = 0; ai < 2; ++ai)
#pragma unroll
            for (int mp = 0; mp < 4; mp += 2) {
                u32x4 gv[2][2], pv[2][2];
#pragma unroll
                for (int mm = 0; mm < 2; ++mm)
#pragma unroll
                    for (int bj = 0; bj < 2; ++bj) { const int row = row0 + ai * HALF + (mp + mm) * 16;
                        gv[mm][bj] = *(const u32x4*)(GT + (size_t)row * 3072 + cg + bj * HALF);
                        if (br > 0) pv[mm][bj] = *(const u32x4*)(MB + (size_t)row * 1024 + cm + bj * HALF); }
                asm volatile("" ::: "memory");
#pragma unroll
                for (int mm = 0; mm < 2; ++mm)
#pragma unroll
                    for (int bj = 0; bj < 2; ++bj) { const int m = mp + mm, row = row0 + ai * HALF + m * 16; const u32x4 g = gv[mm][bj];
                        f32x4 v0 = acc[ai][bj][m][0], v1 = acc[ai][bj][m][1];
                        v0[0] *= __uint_as_float(g.x << 16); v0[1] *= __uint_as_float(g.x & 0xffff0000u); v0[2] *= __uint_as_float(g.y << 16); v0[3] *= __uint_as_float(g.y & 0xffff0000u);
                        v1[0] *= __uint_as_float(g.z << 16); v1[1] *= __uint_as_float(g.z & 0xffff0000u); v1[2] *= __uint_as_float(g.w << 16); v1[3] *= __uint_as_float(g.w & 0xffff0000u);
                        if (br > 0) { const u32x4 p = pv[mm][bj];
                            v0[0] += __uint_as_float(p.x << 16); v0[1] += __uint_as_float(p.x & 0xffff0000u); v0[2] += __uint_as_float(p.y << 16); v0[3] += __uint_as_float(p.y & 0xffff0000u);
                            v1[0] += __uint_as_float(p.z << 16); v1[1] += __uint_as_float(p.z & 0xffff0000u); v1[2] += __uint_as_float(p.w << 16); v1[3] += __uint_as_float(p.w & 0xffff0000u); }
                        u32x4 w; w.x = cvt_pk_bf16(v0[0], v0[1]); w.y = cvt_pk_bf16(v0[2], v0[3]); w.z = cvt_pk_bf16(v1[0], v1[1]); w.w = cvt_pk_bf16(v1[2], v1[3]);
                        *(u32x4*)(MB + (size_t)row * 1024 + cm + bj * HALF) = w; }
                asm volatile("" ::: "memory");
            }
    }
};
template <class Epi, class Sched, bool ALIGN_EPI = false, bool SP2 = false>
__device__ __forceinline__ void gemm_phase(PG8_LAS unsigned char* lds, const Gemm g, const Sched& S, const Epi& E) {
    const int tid = opaque_tid(), wid = __builtin_amdgcn_readfirstlane(tid >> 6), lane = tid & 63, wr = wid >> 2, wc = wid & 3, fr = lane & 15, fq = lane >> 4;
    const int K = g.K, nt = K / BK;
    unsigned voffA[2], voffB[2];
#pragma unroll
    for (int i = 0; i < 2; ++i) { int R, C; stage_rc(tid * 16 + i * 8192, R, C); const int Rb = Epi::PERM ? ((R & ~31) + perm32(R & 31)) : R;
        voffA[i] = (unsigned)(R * g.lda + C) * 2u; voffB[i] = (unsigned)(Rb * g.ldb + C) * 2u; }
    const size_t kstep = (size_t)(BK * 2);
    const size_t hstepA = (size_t)HALF * g.lda * 2, hstepB = (size_t)HALF * g.ldb * 2;
    const size_t tstepA = 2 * hstepA, tstepB = 2 * hstepB;
    const unsigned ldsw = (unsigned)wid * 1024u;
    const int aoff = lds_byte(wr * 64 + fr, fq * 8), boff = lds_byte(wc * 32 + fr, fq * 8);
#define PG8_SA(b, h) (((b) * 2 + (h)) * HTB)
#define PG8_SB(b, h) ((4 + (b) * 2 + (h)) * HTB)
#define PG8_STAGE(bufoff, gbase, voff) do { _Pragma("unroll") for (int _i = 0; _i < 2; ++_i) \
        __builtin_amdgcn_global_load_lds((const unsigned*)((const char*)(gbase) + (voff)[_i]), (PG8_LAS unsigned*)(lds + (bufoff) + ldsw + _i * 8192), 16, 0, 0); } while (0)
#define PG8_LDA(dst, b, h) do { _Pragma("unroll") for (int m = 0; m < 4; ++m) _Pragma("unroll") for (int k = 0; k < 2; ++k) dst[m][k] = *(const PG8_LAS bf16x8*)(lds + PG8_SA(b, h) + aoff + m * 2048 + k * 1024); } while (0)
#define PG8_LDB(dst, b, h) do { _Pragma("unroll") for (int n = 0; n < 2; ++n) _Pragma("unroll") for (int k = 0; k < 2; ++k) dst[n][k] = *(const PG8_LAS bf16x8*)(lds + PG8_SB(b, h) + boff + n * 2048 + k * 1024); } while (0)
#define PG8_MMA(ai, bj, At, Bt) do { __builtin_amdgcn_s_setprio(1); _Pragma("unroll") for (int m = 0; m < 4; ++m) _Pragma("unroll") for (int n = 0; n < 2; ++n) _Pragma("unroll") for (int k = 0; k < 2; ++k) \
        acc[ai][bj][m][n] = __builtin_amdgcn_mfma_f32_16x16x32_bf16(Bt[n][k], At[m][k], acc[ai][bj][m][n], 0, 0, 0); __builtin_amdgcn_s_setprio(0); } while (0)
#define PG8_WAIT_V(n) asm volatile("s_waitcnt vmcnt(" #n ")" ::: "memory")
#define PG8_WAIT_L(n) asm volatile("s_waitcnt lgkmcnt(" #n ")" ::: "memory")
#define PG8_BAR __builtin_amdgcn_s_barrier()
#define PG8_SCHED __builtin_amdgcn_sched_barrier(0)
    Unit cur, nxt; int ui = 0;
    if (!S.next(0, cur)) return;
    f32x4 acc[2][2][4][2];
#pragma unroll
    for (int a = 0; a < 2; ++a)
#pragma unroll
        for (int b = 0; b < 2; ++b)
#pragma unroll
            for (int m = 0; m < 4; ++m)
#pragma unroll
                for (int n = 0; n < 2; ++n) acc[a][b][m][n] = (f32x4){0.f, 0.f, 0.f, 0.f};
    bf16x8 At[4][2], B0[2][2], B1[2][2];
    const char* cA = (const char*)g.A + (size_t)cur.pm * tstepA + (size_t)(cur.pn / g.agrp) * g.astride * 2; const char* cB = (const char*)g.Bt + (size_t)cur.pn * tstepB;
    S.a_ready(cur);
    if constexpr (SP2) {
        PG8_STAGE(PG8_SB(0, 0), cB, voffB); PG8_STAGE(PG8_SB(0, 1), cB + hstepB, voffB); PG8_STAGE(PG8_SA(0, 0), cA, voffA); PG8_STAGE(PG8_SA(0, 1), cA + hstepA, voffA);
        if (wr == 1) PG8_BAR;
        PG8_WAIT_V(2); PG8_BAR;
        PG8_STAGE(PG8_SB(1, 0), cB + kstep, voffB); PG8_STAGE(PG8_SA(1, 0), cA + kstep, voffA); PG8_STAGE(PG8_SB(1, 1), cB + hstepB + kstep, voffB);
        PG8_WAIT_V(6); PG8_BAR;
    } else {
        PG8_STAGE(PG8_SB(0, 0), cB, voffB); PG8_STAGE(PG8_SA(0, 0), cA, voffA); PG8_STAGE(PG8_SB(0, 1), cB + hstepB, voffB); PG8_STAGE(PG8_SA(0, 1), cA + hstepA, voffA);
        if (wr == 1) PG8_BAR;
        PG8_WAIT_V(4); PG8_BAR;
        PG8_STAGE(PG8_SB(1, 0), cB + kstep, voffB); PG8_STAGE(PG8_SA(1, 0), cA + kstep, voffA); PG8_STAGE(PG8_SB(1, 1), cB + hstepB + kstep, voffB);
        PG8_WAIT_V(6); PG8_BAR;
    }
    for (;;) {
        const bool has_next = S.next(ui + 1, nxt);
        const char* nA = has_next ? (const char*)g.A + (size_t)nxt.pm * tstepA + (size_t)(nxt.pn / g.agrp) * g.astride * 2 : cA; const char* nB = has_next ? (const char*)g.Bt + (size_t)nxt.pn * tstepB : cB;
        for (int t = 0; t < nt; t += 2) {
            const bool last = (t == nt - 2);
            const char* a1 = cA + (size_t)(t + 1) * kstep;
            const char* a2 = last ? nA : cA + (size_t)(t + 2) * kstep; const char* b2 = last ? nB : cB + (size_t)(t + 2) * kstep;
            const char* a3 = a2 + kstep; const char* b3 = b2 + kstep;
            if (last && has_next) S.a_ready(nxt);
            if constexpr (SP2) {
            PG8_LDB(B0, 0, 0); PG8_LDB(B1, 0, 1); PG8_SCHED; PG8_LDA(At, 0, 0); PG8_STAGE(PG8_SA(1, 1), a1 + hstepA, voffA);
            PG8_WAIT_V(8); PG8_WAIT_L(0); PG8_BAR; PG8_MMA(0, 0, At, B0); PG8_MMA(0, 1, At, B1); PG8_BAR; PG8_SCHED;
            PG8_LDA(At, 0, 1); PG8_STAGE(PG8_SB(0, 0), b2, voffB); PG8_STAGE(PG8_SB(0, 1), b2 + hstepB, voffB); PG8_STAGE(PG8_SA(0, 0), a2, voffA);
            PG8_WAIT_V(8); PG8_WAIT_L(0); PG8_BAR; PG8_MMA(1, 0, At, B0); PG8_MMA(1, 1, At, B1); PG8_BAR; PG8_SCHED;
            PG8_LDB(B0, 1, 0); PG8_LDB(B1, 1, 1); PG8_SCHED; PG8_LDA(At, 1, 0); PG8_STAGE(PG8_SA(0, 1), a2 + hstepA, voffA);
            PG8_WAIT_V(8); PG8_WAIT_L(0); PG8_BAR; PG8_MMA(0, 0, At, B0); PG8_MMA(0, 1, At, B1); PG8_BAR; PG8_SCHED;
            PG8_LDA(At, 1, 1); PG8_STAGE(PG8_SB(1, 0), b3, voffB); PG8_STAGE(PG8_SB(1, 1), b3 + hstepB, voffB); PG8_STAGE(PG8_SA(1, 0), a3, voffA);
            PG8_WAIT_V(8); PG8_WAIT_L(0); PG8_BAR; PG8_MMA(1, 0, At, B0); PG8_MMA(1, 1, At, B1); PG8_BAR; PG8_SCHED;
            } else {
            PG8_LDB(B0, 0, 0); PG8_SCHED; PG8_LDA(At, 0, 0); PG8_STAGE(PG8_SA(1, 1), a1 + hstepA, voffA);
            PG8_WAIT_L(8); PG8_BAR; PG8_WAIT_L(0); PG8_MMA(0, 0, At, B0); PG8_BAR; PG8_SCHED;
            PG8_LDB(B1, 0, 1); PG8_STAGE(PG8_SB(0, 0), b2, voffB);
            PG8_BAR; PG8_WAIT_L(0); PG8_MMA(0, 1, At, B1); PG8_BAR;
            PG8_LDA(At, 0, 1); PG8_STAGE(PG8_SA(0, 0), a2, voffA);
            PG8_BAR; PG8_WAIT_L(0); PG8_MMA(1, 0, At, B0); PG8_BAR; PG8_SCHED;
            PG8_STAGE(PG8_SB(0, 1), b2 + hstepB, voffB);
            PG8_WAIT_V(6); PG8_BAR; PG8_MMA(1, 1, At, B1); PG8_BAR;
            PG8_LDB(B0, 1, 0); PG8_SCHED; PG8_LDA(At, 1, 0); PG8_STAGE(PG8_SA(0, 1), a2 + hstepA, voffA);
            PG8_WAIT_L(8); PG8_BAR; PG8_WAIT_L(0); PG8_MMA(0, 0, At, B0); PG8_BAR; PG8_SCHED;
            PG8_LDB(B1, 1, 1); PG8_STAGE(PG8_SB(1, 0), b3, voffB);
            PG8_BAR; PG8_WAIT_L(0); PG8_MMA(0, 1, At, B1); PG8_BAR;
            PG8_LDA(At, 1, 1); PG8_STAGE(PG8_SA(1, 0), a3, voffA);
            PG8_BAR; PG8_WAIT_L(0); PG8_MMA(1, 0, At, B0); PG8_BAR; PG8_SCHED;
            PG8_STAGE(PG8_SB(1, 1), b3 + hstepB, voffB);
            PG8_WAIT_V(6); PG8_BAR; PG8_MMA(1, 1, At, B1); PG8_BAR;
            }
        }
        if constexpr (ALIGN_EPI) { if (wr == 0) PG8_BAR; }
        if constexpr (!Epi::AFTER_DRAIN) { E(acc, cur, wr, wc, fr, fq); S.done(cur); }
        if (!has_next) break;
#pragma unroll
        for (int a = 0; a < 2; ++a)
#pragma unroll
            for (int b = 0; b < 2; ++b)
#pragma unroll
                for (int m = 0; m < 4; ++m)
#pragma unroll
                    for (int n = 0; n < 2; ++n) acc[a][b][m][n] = (f32x4){0.f, 0.f, 0.f, 0.f};
        cur = nxt; cA = nA; cB = nB; ++ui;
        if constexpr (ALIGN_EPI) { if (wr == 1) PG8_BAR; }
    }
    PG8_WAIT_V(0);
    if constexpr (!ALIGN_EPI) { if (wr == 0) PG8_BAR; }
    PG8_BAR;
    if constexpr (Epi::AFTER_DRAIN) { E.fused(acc, cur, wr, wc, fr, fq, lds, wid, lane); S.done(cur); }
#undef PG8_SA
#undef PG8_SB
#undef PG8_STAGE
#undef PG8_LDA
#undef PG8_LDB
#undef PG8_MMA
#undef PG8_WAIT_V
#undef PG8_WAIT_L
#undef PG8_BAR
#undef PG8_SCHED
}
}

#define LAS __attribute__((address_space(3)))
typedef unsigned short bf16_t;
constexpr int D = 1024, NBATCH = 2, SEQ = 16384, T = NBATCH * SEQ, DFF = 2816, NIN = 5632, PW = 2560, GW = 3072, QKW = 640;
constexpr float EPS = 1e-6f, LOG2E = 1.4426950408889634f, C2 = 0.125f * 1.4426950408889634f;
constexpr size_t MiB = 1u << 20;
constexpr size_t WS_SS = 0;
constexpr size_t WS_LAM = 1 * MiB;
constexpr size_t WS_LUT = 1 * MiB + 256;
constexpr size_t WS_BAR = MiB + MiB / 2, WS_BAR_BYTES = 16384;
constexpr size_t WS_W = 2 * MiB, W_LAYER = 53 * MiB;
constexpr size_t W_1IN = 0, W_1OUT = 11 * MiB, W_IN = 16 * MiB + MiB / 2, W_B = 27 * MiB + MiB / 2, W_O3 = 30 * MiB + MiB / 2, W_2IN = 36 * MiB + MiB / 2, W_2OUT = 47 * MiB + MiB / 2;
constexpr size_t WS_XB = 108 * MiB;
constexpr size_t WS_R2 = 172 * MiB;
constexpr size_t WS_P = 348 * MiB;
constexpr size_t WS_QK = 428 * MiB;
constexpr size_t WS_O1 = 468 * MiB;
constexpr size_t WS_END = 500 * MiB;
constexpr int LDS_BYTES = 147456;

typedef unsigned v4u __attribute__((ext_vector_type(4)));
typedef float f32x4 __attribute__((ext_vector_type(4)));
#define LDS_WAIT() asm volatile("s_waitcnt lgkmcnt(0)" ::: "memory")
__device__ __forceinline__ unsigned f2bf(float f) { unsigned u = __float_as_uint(f); return (u + 0x7fffu + ((u >> 16) & 1u)) >> 16; }
__device__ __forceinline__ unsigned pk2(float lo, float hi) { return f2bf(lo) | (f2bf(hi) << 16); }
__device__ __forceinline__ float wave_sum(float v) {
#pragma unroll
    for (int o = 1; o < 64; o <<= 1) v += __shfl_xor(v, o);
    return v;
}

namespace att {
typedef short bf16x8 __attribute__((ext_vector_type(8)));
typedef short s16x4 __attribute__((ext_vector_type(4)));
typedef float f32x16 __attribute__((ext_vector_type(16)));
typedef unsigned u32x4 __attribute__((ext_vector_type(4)));
typedef unsigned u32x2 __attribute__((ext_vector_type(2)));
typedef float f32x2_t __attribute__((ext_vector_type(2)));
typedef __bf16 bf16x2_t __attribute__((ext_vector_type(2)));
__device__ __forceinline__ unsigned cvtpk(float lo, float hi) { f32x2_t v = {lo, hi}; bf16x2_t b = __builtin_convertvector(v, bf16x2_t); return __builtin_bit_cast(unsigned, b); }
__device__ __forceinline__ int crow(int r, int hi) { return (r & 3) + 8 * (r >> 2) + 4 * hi; }
__device__ __forceinline__ float swapmax(float m) { auto rr = __builtin_amdgcn_permlane32_swap(__float_as_uint(m), __float_as_uint(m), false, false); return fmaxf(__uint_as_float(rr[0]), __uint_as_float(rr[1])); }
__device__ __forceinline__ float swapsum(float m) { auto rr = __builtin_amdgcn_permlane32_swap(__float_as_uint(m), __float_as_uint(m), false, false); return __uint_as_float(rr[0]) + __uint_as_float(rr[1]); }
typedef short v4i16_t __attribute__((ext_vector_type(4)));
__device__ __forceinline__ s16x4 vtr(const LAS unsigned char* p) { return __builtin_bit_cast(s16x4, __builtin_amdgcn_ds_read_tr16_b64_v4i16((LAS v4i16_t*)p)); }
constexpr int K_OFF = 0, V_OFF = 32768, LUT_OFF = 98304;
__device__ __forceinline__ void glds16(const void* gsrc, unsigned lds_dst) { unsigned keep;
    asm volatile("s_mov_b32 %0, m0\n\ts_mov_b32 m0, %2\n\ts_nop 0\n\tglobal_load_lds_dwordx4 %1, off\n\ts_mov_b32 m0, %0" : "=&s"(keep) : "v"(gsrc), "s"(lds_dst) : "memory"); }
constexpr float THR = 4.0f;
#define ATT_BAR() asm volatile("s_waitcnt lgkmcnt(0)\n\ts_barrier" ::: "memory")
#define ATT_BAR_S(a, b) asm volatile("s_waitcnt lgkmcnt(0)\n\ts_barrier" : "+v"(a), "+v"(b) :: "memory")
#define ATT_BAR_P(p) asm volatile("s_barrier" : "+v"(p[0]), "+v"(p[1]), "+v"(p[2]), "+v"(p[3]) :: "memory")
__device__ __forceinline__ float max3f(float a, float b, float c) { float r; asm("v_max3_f32 %0, %1, %2, %3" : "=v"(r) : "v"(a), "v"(b), "v"(c)); return r; }

template <int NDB>
__device__ __forceinline__ void pv_block(const LAS unsigned char* Vb, const bf16x8 (&pf)[4], f32x16 (&o)[NDB]) {
    bf16x8 vf[2][NDB];
#pragma unroll
    for (int db = 0; db < NDB; ++db) { const s16x4 lo = vtr(Vb + db * 4096), hh = vtr(Vb + db * 4096 + 512); vf[0][db] = (bf16x8){lo[0], lo[1], lo[2], lo[3], hh[0], hh[1], hh[2], hh[3]}; }
    __builtin_amdgcn_sched_barrier(0);
#pragma unroll
    for (int ks = 0; ks < 4; ++ks) {
        if (ks < 3) {
#pragma unroll
            for (int db = 0; db < NDB; ++db) { const s16x4 lo = vtr(Vb + db * 4096 + (ks + 1) * 1024), hh = vtr(Vb + db * 4096 + (ks + 1) * 1024 + 512); vf[(ks + 1) & 1][db] = (bf16x8){lo[0], lo[1], lo[2], lo[3], hh[0], hh[1], hh[2], hh[3]}; }
        }
#pragma unroll
        for (int db = 0; db < NDB; ++db) o[db] = __builtin_amdgcn_mfma_f32_32x32x16_bf16(vf[ks & 1][db], pf[ks], o[db], 0, 0, 0);
        __builtin_amdgcn_sched_barrier(0);
    }
}

template <int DV, int MODE>
__device__ __forceinline__ void attn_pass(LAS unsigned char* lds, const bf16_t* __restrict__ Kp, const bf16_t* __restrict__ Vp, int kt0, int kt1,
                                          const bf16x8 (&qr)[4], f32x16 (&o)[DV / 32], float& m_io, float& l_io, int qpos, float cL, float cR) {
    constexpr int NDB = DV / 32, NVP = DV / 64;
    const int tid = opaque_tid(), lane = tid & 63, wid = __builtin_amdgcn_readfirstlane(tid >> 6), r32 = lane & 31, hi = lane >> 5;
    const int grp = __builtin_amdgcn_readfirstlane((int)((const volatile LAS unsigned*)(lds + 131072 + 64))[8 + wid]);
    const LAS float* lut = (const LAS float*)(lds + LUT_OFF);
    const unsigned ldsb = (unsigned)(uintptr_t)lds;
    const bf16_t* ksrc = Kp + (size_t)lane * PW + wid * 8;
    const unsigned kdst = ldsb + K_OFF + wid * 1024;
    const bf16_t* vsrc[NVP]; unsigned vdst[NVP];
#pragma unroll
    for (int j = 0; j < NVP; ++j) { const int p = wid + 8 * j, db = p >> 2, kvq = p & 3; vsrc[j] = Vp + (size_t)(16 * kvq + (lane >> 2)) * PW + db * 32 + (lane & 3) * 8; vdst[j] = ldsb + V_OFF + p * 1024; }
    const int nt = kt1 - kt0;
#define DMA_K(tt, slot) glds16(ksrc + (size_t)(tt) * 64 * PW, (unsigned)__builtin_amdgcn_readfirstlane(kdst + (slot) * 8192))
#define DMA_V(tt, slot) do { _Pragma("unroll") for (int j_ = 0; j_ < NVP; ++j_) glds16(vsrc[j_] + (size_t)(tt) * 64 * PW, (unsigned)__builtin_amdgcn_readfirstlane(vdst[j_] + (slot) * 16384)); } while (0)
    DMA_K(kt0, 0); DMA_V(kt0, 0); DMA_K(kt0 + 1, 1); DMA_V(kt0 + 1, 1); DMA_K(kt0 + 2, 2);
    asm volatile("s_waitcnt vmcnt(0)" ::: "memory");
    __syncthreads();
    float m = (MODE == 2) ? -1e30f : 0.f, l = 0.f;
#pragma unroll
    for (int db = 0; db < NDB; ++db)
#pragma unroll
        for (int r = 0; r < 16; ++r) o[db][r] = 0.f;
    const int kaddr = hi * 1024 + r32 * 16;
    const int vaddr = (4 * hi + ((lane & 15) >> 2)) * 64 + ((lane >> 4) & 1) * 32 + (lane & 3) * 8;
    auto tile_c = [&](int t) -> float { if (MODE != 1) return 0.f; const int k0 = t * 64; return (k0 + 63 - qpos <= -128) ? cL : ((k0 - (qpos + 31) >= 128) ? cR : 0.f); };
    auto tile_near = [&](int t) -> bool { if (MODE == 0 || MODE == 3) return false; if (MODE == 2) return true; const int k0 = t * 64; return !(k0 + 63 - qpos <= -128) && !(k0 - (qpos + 31) >= 128); };
    float ccur = tile_c(kt0);
    f32x16 negm;
#pragma unroll
    for (int r = 0; r < 16; ++r) negm[r] = ccur;
    asm volatile("" : "+v"(negm));
    bf16x8 pf[4]; f32x16 s0, s1;
    bf16x8 kf[8];
#define LOAD_KF(slot) do { const LAS unsigned char* Kb_ = lds + K_OFF + (slot) * 8192 + kaddr; _Pragma("unroll") for (int d0_ = 0; d0_ < 4; ++d0_) { kf[2 * d0_] = *(const LAS bf16x8*)(Kb_ + d0_ * 2048); kf[2 * d0_ + 1] = *(const LAS bf16x8*)(Kb_ + d0_ * 2048 + 512); } } while (0)
    LOAD_KF(0);
    if (grp == 1) ATT_BAR();
    for (int i = 0; i < nt; ++i) {
        const int t = kt0 + i;
        const int sk = i & 3, sv = (i + 3) & 3;
        const bool steady = (i + 3 < nt);
        __builtin_amdgcn_s_setprio(1);
        const bool dv = (i + 2 < nt);
        if (MODE == 3) { const f32x16 z = {0.f, 0.f, 0.f, 0.f, 0.f, 0.f, 0.f, 0.f, 0.f, 0.f, 0.f, 0.f, 0.f, 0.f, 0.f, 0.f};
            s0 = __builtin_amdgcn_mfma_f32_32x32x16_bf16(kf[0], qr[0], z, 0, 0, 0); s1 = __builtin_amdgcn_mfma_f32_32x32x16_bf16(kf[1], qr[0], z, 0, 0, 0); }
        else { s0 = __builtin_amdgcn_mfma_f32_32x32x16_bf16(kf[0], qr[0], negm, 0, 0, 0); s1 = __builtin_amdgcn_mfma_f32_32x32x16_bf16(kf[1], qr[0], negm, 0, 0, 0); }
        __builtin_amdgcn_sched_barrier(0);
        if (steady) DMA_K(t + 3, (i + 3) & 3);
        __builtin_amdgcn_sched_barrier(0);
        s0 = __builtin_amdgcn_mfma_f32_32x32x16_bf16(kf[2], qr[1], s0, 0, 0, 0); s1 = __builtin_amdgcn_mfma_f32_32x32x16_bf16(kf[3], qr[1], s1, 0, 0, 0);
        __builtin_amdgcn_sched_barrier(0);
        if (dv) glds16(vsrc[0] + (size_t)(t + 2) * 64 * PW, (unsigned)__builtin_amdgcn_readfirstlane(vdst[0] + ((i + 2) & 3) * 16384));
        __builtin_amdgcn_sched_barrier(0);
        s0 = __builtin_amdgcn_mfma_f32_32x32x16_bf16(kf[4], qr[2], s0, 0, 0, 0); s1 = __builtin_amdgcn_mfma_f32_32x32x16_bf16(kf[5], qr[2], s1, 0, 0, 0);
        __builtin_amdgcn_sched_barrier(0);
        if (NVP == 2) { if (dv) glds16(vsrc[NVP - 1] + (size_t)(t + 2) * 64 * PW, (unsigned)__builtin_amdgcn_readfirstlane(vdst[NVP - 1] + ((i + 2) & 3) * 16384)); }
        __builtin_amdgcn_sched_barrier(0);
        s0 = __builtin_amdgcn_mfma_f32_32x32x16_bf16(kf[6], qr[3], s0, 0, 0, 0); s1 = __builtin_amdgcn_mfma_f32_32x32x16_bf16(kf[7], qr[3], s1, 0, 0, 0);
        __builtin_amdgcn_sched_barrier(0);
        if (i > 0) pv_block<NDB>(lds + V_OFF + sv * 16384 + vaddr, pf, o);
        __builtin_amdgcn_s_setprio(0);
        if (i == 0) asm volatile("s_nop 15\n\ts_nop 15\n\ts_nop 15\n\ts_nop 15\n\ts_nop 15" ::: "memory");
        ATT_BAR_S(s0, s1);
        if (MODE == 1 || MODE == 2) {
            if (tile_near(t)) {
                const int rel0 = t * 64 - (qpos + r32) + 4 * hi;
#pragma unroll
                for (int r = 0; r < 16; ++r) {
                    const int rel = rel0 + (r & 3) + 8 * (r >> 2), rel1 = rel + 32;
                    const int i0 = min(max(rel, -128), 128) + 128, i1 = min(max(rel1, -128), 128) + 128;
                    s0[r] += lut[i0]; s1[r] += lut[i1];
                    if (MODE == 2) { if (rel < -128 || rel > 128) s0[r] = -__builtin_inff(); if (rel1 < -128 || rel1 > 128) s1[r] = -__builtin_inff(); }
                }
            }
        }
        if (i + 1 < nt) LOAD_KF((i + 1) & 3);
        __builtin_amdgcn_sched_barrier(0);
        float mx = 0.f;
        if (MODE != 3) {
            float mx2;
            mx = max3f(s0[0], s1[0], s0[1]); mx2 = max3f(s1[1], s0[2], s1[2]);
#pragma unroll
            for (int r = 3; r < 15; r += 2) { mx = max3f(mx, s0[r], s1[r]); mx2 = max3f(mx2, s0[r + 1], s1[r + 1]); }
            mx = max3f(mx, s0[15], s1[15]); mx = max3f(mx, mx2, mx2);
            mx = swapmax(mx);
        }
        bool changed = false;
        if (MODE == 3) {
        } else if (MODE == 2) {
            if (__any(mx > m + THR)) {
                const float mn = fmaxf(m, mx), a = __builtin_amdgcn_exp2f(m - mn);
                l *= a;
#pragma unroll
                for (int db = 0; db < NDB; ++db)
#pragma unroll
                    for (int r = 0; r < 16; ++r) o[db][r] *= a;
                m = mn;
            }
#pragma unroll
            for (int r = 0; r < 16; ++r) { s0[r] -= m; s1[r] -= m; }
        } else {
            if (i == 0) {
                m = mx; changed = true;
#pragma unroll
                for (int r = 0; r < 16; ++r) { s0[r] -= mx; s1[r] -= mx; }
            } else if (__any(mx > THR)) {
                const float dl = fmaxf(mx, 0.f), a = __builtin_amdgcn_exp2f(-dl);
                m += dl; l *= a; changed = true;
#pragma unroll
                for (int r = 0; r < 16; ++r) { s0[r] -= dl; s1[r] -= dl; }
#pragma unroll
                for (int db = 0; db < NDB; ++db)
#pragma unroll
                    for (int r = 0; r < 16; ++r) o[db][r] *= a;
            }
        }
        float ps = 0.f;
#pragma unroll
        for (int r = 0; r < 16; ++r) { s0[r] = __builtin_amdgcn_exp2f(s0[r]); s1[r] = __builtin_amdgcn_exp2f(s1[r]); ps += s0[r] + s1[r]; }
        l += ps;
        { u32x4 w;
          w.x = cvtpk(s0[0], s0[1]); w.y = cvtpk(s0[2], s0[3]); w.z = cvtpk(s0[4], s0[5]); w.w = cvtpk(s0[6], s0[7]); pf[0] = __builtin_bit_cast(bf16x8, w);
          w.x = cvtpk(s0[8], s0[9]); w.y = cvtpk(s0[10], s0[11]); w.z = cvtpk(s0[12], s0[13]); w.w = cvtpk(s0[14], s0[15]); pf[1] = __builtin_bit_cast(bf16x8, w);
          w.x = cvtpk(s1[0], s1[1]); w.y = cvtpk(s1[2], s1[3]); w.z = cvtpk(s1[4], s1[5]); w.w = cvtpk(s1[6], s1[7]); pf[2] = __builtin_bit_cast(bf16x8, w);
          w.x = cvtpk(s1[8], s1[9]); w.y = cvtpk(s1[10], s1[11]); w.z = cvtpk(s1[12], s1[13]); w.w = cvtpk(s1[14], s1[15]); pf[3] = __builtin_bit_cast(bf16x8, w); }
        if (MODE != 2 && MODE != 3) {
            const float cnext = tile_c(t + 1);
            if (changed || cnext != ccur) { ccur = cnext; const float v = ccur - m;
#pragma unroll
                for (int r = 0; r < 16; ++r) negm[r] = v;
                asm volatile("" : "+v"(negm)); }
        }
        if (steady) { if (NVP == 1) asm volatile("s_waitcnt vmcnt(2)" ::: "memory"); else asm volatile("s_waitcnt vmcnt(3)" ::: "memory"); }
        else asm volatile("s_waitcnt vmcnt(0)" ::: "memory");
        ATT_BAR_P(pf);
    }
    pv_block<NDB>(lds + V_OFF + ((nt + 3) & 3) * 16384 + vaddr, pf, o);
    if (grp == 0) ATT_BAR();
    __syncthreads();
#undef DMA_K
#undef DMA_V
#undef LOAD_KF
    m_io = m; l_io = l;
}

__device__ __forceinline__ void load_q(bf16x8 (&qr)[4], const bf16_t* Qrow, int hi) {
#pragma unroll
    for (int d0 = 0; d0 < 4; ++d0) qr[d0] = *(const bf16x8*)(Qrow + d0 * 16 + hi * 8);
}
template <int NDB>
__device__ __forceinline__ void store_o(bf16_t* Orow, const f32x16 (&o)[NDB], int hi) {
#pragma unroll
    for (int db = 0; db < NDB; ++db)
#pragma unroll
        for (int gp = 0; gp < 2; ++gp) {
            const unsigned x0 = cvtpk(o[db][8 * gp], o[db][8 * gp + 1]), x1 = cvtpk(o[db][8 * gp + 2], o[db][8 * gp + 3]);
            const unsigned y0 = cvtpk(o[db][8 * gp + 4], o[db][8 * gp + 5]), y1 = cvtpk(o[db][8 * gp + 6], o[db][8 * gp + 7]);
            const auto r0 = __builtin_amdgcn_permlane32_swap(x0, y0, false, false), r1 = __builtin_amdgcn_permlane32_swap(x1, y1, false, false);
            u32x4 w; w.x = r0[0]; w.y = r1[0]; w.z = r0[1]; w.w = r1[1];
            *(u32x4*)(Orow + 32 * db + 16 * gp + 8 * hi) = w; }
}

__device__ __forceinline__ void load_q_a(bf16x8 (&qr)[4], const float* qsrc, const float* gq, int tpos, int hi) {
    float x[4][8];
#pragma unroll
    for (int d0 = 0; d0 < 4; ++d0) { const f32x4 a = *(const f32x4*)(qsrc + 16 * d0 + 8 * hi), b = *(const f32x4*)(qsrc + 16 * d0 + 8 * hi + 4);
#pragma unroll
        for (int e = 0; e < 4; ++e) { x[d0][e] = a[e]; x[d0][4 + e] = b[e]; } }
    float ss = 0.f;
#pragma unroll
    for (int d0 = 0; d0 < 4; ++d0)
#pragma unroll
        for (int j = 0; j < 8; ++j) ss += x[d0][j] * x[d0][j];
    ss = swapsum(ss);
    const float r = __builtin_amdgcn_rsqf(ss * (1.0f / 64.0f) + EPS);
#pragma unroll
    for (int hf = 0; hf < 2; ++hf) {
        const float pos = (float)(hf ? (tpos & 63) : (tpos >> 6));
        u32x4 w1, w2;
#pragma unroll
        for (int j = 0; j < 8; j += 2) {
            float y1[2], y2[2];
#pragma unroll
            for (int e = 0; e < 2; ++e) { const int i = 8 * hi + j + e;
                const float freq = __builtin_amdgcn_exp2f(-(float)i * (13.287712379549449f / 16.0f));
                float rev = pos * freq * 0.15915494309189535f; rev -= floorf(rev);
                const float sn = __builtin_amdgcn_sinf(rev), cs = __builtin_amdgcn_cosf(rev);
                const float a1 = x[2 * hf][j + e] * r * gq[32 * hf + i], a2 = x[2 * hf + 1][j + e] * r * gq[32 * hf + 16 + i];
                y1[e] = (a1 * cs - a2 * sn) * C2; y2[e] = (a1 * sn + a2 * cs) * C2; }
            w1[j >> 1] = cvtpk(y1[0], y1[1]); w2[j >> 1] = cvtpk(y2[0], y2[1]);
        }
        qr[2 * hf] = __builtin_bit_cast(bf16x8, w1); qr[2 * hf + 1] = __builtin_bit_cast(bf16x8, w2);
    }
}
__device__ __forceinline__ void unit_a(LAS unsigned char* lds, bf16_t* P, const float* QKs, const float* gq, int h, int qb, bool bounded) {
    const int tid = opaque_tid(), lane = tid & 63, wid = __builtin_amdgcn_readfirstlane(tid >> 6), r32 = lane & 31, hi = lane >> 5;
    const int qpos = qb * 256 + wid * 32;
    bf16_t* Qrow = P + (size_t)(qpos + r32) * PW + h * 64;
    bf16x8 qr[4]; load_q_a(qr, QKs + (size_t)(qpos + r32) * QKW + h * 64, gq, qpos + r32, hi);
    f32x16 o[2]; float m, l;
    if (bounded) attn_pass<64, 3>(lds, P + 512 + (h >> 2) * 64, P + 640 + (h >> 2) * 64, 0, SEQ / 64, qr, o, m, l, qpos, 0.f, 0.f);
    else attn_pass<64, 0>(lds, P + 512 + (h >> 2) * 64, P + 640 + (h >> 2) * 64, 0, SEQ / 64, qr, o, m, l, qpos, 0.f, 0.f);
    l = swapsum(l); const float inv = 1.0f / l;
#pragma unroll
    for (int db = 0; db < 2; ++db)
#pragma unroll
        for (int r = 0; r < 16; ++r) o[db][r] *= inv;
    store_o<2>(Qrow, o, hi);
}
__device__ __forceinline__ void unit_b(LAS unsigned char* lds, bf16_t* P, int h, int qb, const float* lutg, float sink_l2) {
    const int tid = opaque_tid(), lane = tid & 63, wid = __builtin_amdgcn_readfirstlane(tid >> 6), r32 = lane & 31, hi = lane >> 5;
    LAS float* lut = (LAS float*)(lds + LUT_OFF);
    if (tid < 257) lut[tid] = lutg[h * 257 + tid];
    const int q0 = qb * 256, qpos = q0 + wid * 32;
    bf16_t* Qrow = P + (size_t)(qpos + r32) * PW + 768 + h * 64;
    bf16x8 qr[4]; load_q(qr, Qrow, hi);
    int kt0 = (q0 - 128) / 64, kt1 = (q0 + 384) / 64; if (q0 < 128) kt0 = 0; if (kt1 > SEQ / 64) kt1 = SEQ / 64;
    f32x16 o[2]; float m, l;
    attn_pass<64, 2>(lds, P + 1280 + (h >> 2) * 64, P + 1408 + (h >> 2) * 64, kt0, kt1, qr, o, m, l, qpos, 0.f, 0.f);
    l = swapsum(l);
    const float mf = fmaxf(m, sink_l2), a = __builtin_amdgcn_exp2f(m - mf);
    l = l * a + __builtin_amdgcn_exp2f(sink_l2 - mf);
    const float inv = a / l;
#pragma unroll
    for (int db = 0; db < 2; ++db)
#pragma unroll
        for (int r = 0; r < 16; ++r) o[db][r] *= inv;
    store_o<2>(Qrow, o, hi);
}
__device__ __forceinline__ void unit_c(LAS unsigned char* lds, bf16_t* P, int h, int qb, const float* lutg, float lam, float one_m_li, const float* subln, float* stash) {
    const int tid = opaque_tid(), lane = tid & 63, wid = __builtin_amdgcn_readfirstlane(tid >> 6), r32 = lane & 31, hi = lane >> 5;
    LAS float* lut = (LAS float*)(lds + LUT_OFF);
    if (tid < 257) lut[tid] = lutg[(8 + h) * 257 + tid];
    const float cL = lutg[(8 + h) * 257 + 0], cR = lutg[(8 + h) * 257 + 256];
    const int qpos = qb * 256 + wid * 32;
    bf16_t* Qrow = P + (size_t)(qpos + r32) * PW + 1536 + h * 128;
    const bf16_t* Kp = P + 2048 + (h >> 1) * 128; const bf16_t* Vp = P + 2304 + (h >> 1) * 128;
    f32x16 o[4]; float m, l;
    { bf16x8 qr[4]; load_q(qr, Qrow, hi);
      attn_pass<128, 1>(lds, Kp, Vp, 0, SEQ / 64, qr, o, m, l, qpos, cL, cR); }
    f32x4* st = (f32x4*)(stash + (size_t)tid * 64);
    l = swapsum(l); { const float inv = 1.0f / l;
#pragma unroll
    for (int db = 0; db < 4; ++db)
#pragma unroll
        for (int g4 = 0; g4 < 4; ++g4) st[db * 4 + g4] = (f32x4){o[db][4 * g4] * inv, o[db][4 * g4 + 1] * inv, o[db][4 * g4 + 2] * inv, o[db][4 * g4 + 3] * inv}; }
    asm volatile("" ::: "memory");
    { bf16x8 qr[4]; load_q(qr, Qrow + 64, hi);
      attn_pass<128, 1>(lds, Kp + 64, Vp, 0, SEQ / 64, qr, o, m, l, qpos, cL, cR); }
    l = swapsum(l); const float inv2 = lam / l; float ss = 0.f;
#pragma unroll
    for (int db = 0; db < 4; ++db)
#pragma unroll
        for (int g4 = 0; g4 < 4; ++g4) { const f32x4 s4 = st[db * 4 + g4];
#pragma unroll
            for (int e = 0; e < 4; ++e) { const float v = s4[e] - o[db][4 * g4 + e] * inv2; o[db][4 * g4 + e] = v; ss += v * v; } }
    ss = swapsum(ss);
    const float rs = __builtin_amdgcn_rsqf(ss * (1.0f / 128.0f) + EPS) * one_m_li;
#pragma unroll
    for (int db = 0; db < 4; ++db)
#pragma unroll
        for (int r = 0; r < 16; ++r) o[db][r] *= rs * subln[32 * db + crow(r, hi)];
    store_o<4>(Qrow, o, hi);
}
}
__device__ __forceinline__ void tr_item(const float* __restrict__ W, int ldn, int k0, int nsrc0, bf16_t* WT, int ldk, int ndst0, int nrep, int repstride, const float* gain, LAS float* scr, int lane) {
    f32x4 wv[8];
#pragma unroll
    for (int i = 0; i < 8; ++i) wv[i] = *(const f32x4*)(W + (size_t)(k0 + 8 * i + (lane >> 3)) * ldn + nsrc0 + (lane & 7) * 4);
#pragma unroll
    for (int i = 0; i < 8; ++i) { const int kk = 8 * i + (lane >> 3); const float gsc = gain ? gain[k0 + kk] : 1.0f; LAS float* d = scr + kk * 33 + (lane & 7) * 4;
        d[0] = wv[i][0] * gsc; d[1] = wv[i][1] * gsc; d[2] = wv[i][2] * gsc; d[3] = wv[i][3] * gsc; }
    LDS_WAIT();
    const int c = lane & 7;
#pragma unroll
    for (int j = 0; j < 4; ++j) { const int n = (lane >> 3) + 8 * j; const LAS float* s = scr + (8 * c) * 33 + n;
        v4u o; o.x = pk2(s[0 * 33], s[1 * 33]); o.y = pk2(s[2 * 33], s[3 * 33]); o.z = pk2(s[4 * 33], s[5 * 33]); o.w = pk2(s[6 * 33], s[7 * 33]);
        for (int rep = 0; rep < nrep; ++rep) *(v4u*)(WT + (size_t)(ndst0 + n) * ldk + rep * repstride + k0 + 8 * c) = o; }
    LDS_WAIT();
}
__device__ __forceinline__ int t5_bucket(int rel) {
    const int n = rel < 0 ? -rel : rel; int b;
    if (n < 8) b = n; else { int k = 0; while (k < 8 && (64 << (k + 1)) <= n * n) ++k; b = 8 + k; if (b > 15) b = 15; }
    return (rel > 0 ? 16 : 0) + b;
}

#define XB_TMO      128
#define XB_XCNT(j)  (256  + 64 * (j))
#define XB_XSUB(j)  (1280 + 64 * (j))
#define XB_XGEN(j)  (2304 + 64 * (j))
#define XB_TOP      3328
#define XB_TOPGEN   3392
#define XCD_BAR_WORDS 3456
#define XB_SPIN_CAP (1u << 18)

__device__ __forceinline__ unsigned xb_ld(unsigned* p)              { return __hip_atomic_load(p, __ATOMIC_RELAXED, __HIP_MEMORY_SCOPE_AGENT); }
__device__ __forceinline__ unsigned xb_add(unsigned* p, unsigned v) { return __hip_atomic_fetch_add(p, v, __ATOMIC_RELAXED, __HIP_MEMORY_SCOPE_AGENT); }
__device__ __forceinline__ unsigned xb_xcc_id() { return (unsigned)__builtin_amdgcn_s_getreg((3 << 11) | 20) & 0xFu; }
#define XB_SPIN(cond, bar) do { unsigned _sp = 0; while (cond) { __builtin_amdgcn_s_sleep(1); \
    if ((++_sp & 255u) == 0u) { if (xb_ld(&(bar)[XB_TMO])) break; if (_sp > XB_SPIN_CAP) { atomicAdd(&(bar)[XB_TMO], 1u); break; } } } } while (0)

struct XcdBarrier {
    unsigned* bar; unsigned x;
    volatile LAS unsigned* st;
};

__device__ __forceinline__ XcdBarrier xcd_barrier_post(unsigned* bar, volatile LAS unsigned* st) {
    XcdBarrier b; b.bar = bar; b.x = xb_xcc_id(); b.st = st;
    if (threadIdx.x == 0) (void)xb_add(&bar[XB_XCNT(b.x)], 1u);
    return b;
}
__device__ __forceinline__ void xcd_barrier_complete(unsigned* bar, unsigned x, unsigned& nloc, unsigned& nx) {
    const unsigned G = gridDim.x * gridDim.y * gridDim.z;
    unsigned sum, cnt, mine, sp = 0u;
    for (;;) {
        sum = 0u; cnt = 0u; mine = 0u;
#pragma unroll
        for (unsigned j = 0; j < 16; ++j) { const unsigned c = xb_ld(&bar[XB_XCNT(j)]); sum += c; cnt += (c > 0u) ? 1u : 0u; mine = (j == x) ? c : mine; }
        if (sum == G) break;
        __builtin_amdgcn_s_sleep(1);
        if ((++sp & 255u) == 0u) { if (xb_ld(&bar[XB_TMO])) break; if (sp > XB_SPIN_CAP) { atomicAdd(&bar[XB_TMO], 1u); break; } }
    }
    nloc = mine > 0u ? mine : 1u; nx = cnt > 0u ? cnt : 1u;
}

__device__ __forceinline__ void xcd_barrier(const XcdBarrier& b) {
    asm volatile("s_waitcnt vmcnt(0)" ::: "memory");
    __syncthreads();
    if (threadIdx.x == 0) {
        unsigned* bar = b.bar;
        __builtin_amdgcn_s_waitcnt(0);
        unsigned nloc = b.st[0], nx = b.st[1];
        if (nloc == 0u) { xcd_barrier_complete(bar, b.x, nloc, nx); b.st[0] = nloc; b.st[1] = nx; }
        const unsigned old = xb_add(&bar[XB_XSUB(b.x)], 1u);
        const unsigned gen = old / nloc;
        if (old + 1u == (gen + 1u) * nloc) {
            __builtin_amdgcn_fence(__ATOMIC_RELEASE, "agent");
            asm volatile("s_waitcnt vmcnt(0)" ::: "memory");
            const unsigned og = xb_add(&bar[XB_TOP], 1u);
            const unsigned tg = og / nx;
            if (og + 1u == (tg + 1u) * nx) xb_add(&bar[XB_TOPGEN], 1u);
            else XB_SPIN(xb_ld(&bar[XB_TOPGEN]) == tg, bar);
            __builtin_amdgcn_fence(__ATOMIC_ACQUIRE, "agent");
            xb_add(&bar[XB_XGEN(b.x)], 1u);
            asm volatile("s_waitcnt vmcnt(0)" ::: "memory");
        } else {
            XB_SPIN(xb_ld(&bar[XB_XGEN(b.x)]) == gen, bar);
            __builtin_amdgcn_fence(__ATOMIC_ACQUIRE, "agent");
            asm volatile("s_waitcnt vmcnt(0)" ::: "memory");
        }
    }
    __syncthreads();
}

struct Args { const float* in[21]; float* out; unsigned char* ws; };
__global__ void __launch_bounds__(512, 2) fwd_megakernel(Args a) {
    extern __shared__ __attribute__((aligned(16))) unsigned char lds_raw[];
    LAS unsigned char* lds = (LAS unsigned char*)lds_raw;
    cg::grid_group grid = cg::this_grid();
    const int tid = opaque_tid(), lane = tid & 63, wave = __builtin_amdgcn_readfirstlane(tid >> 6);
    const int G = gridDim.x, bx = blockIdx.x;
    const int vcu = (G % 8 == 0) ? (bx % 8) * (G / 8) + bx / 8 : bx;
    const int gw = vcu * 8 + wave, NGW = G * 8;
    unsigned char* ws = a.ws;
    float* ssb = (float*)(ws + WS_SS);
    float* lamb = (float*)(ws + WS_LAM);
    float* lutg = (float*)(ws + WS_LUT);
    bf16_t* XB = (bf16_t*)(ws + WS_XB);
    bf16_t* ACT = (bf16_t*)(ws + WS_R2);
    bf16_t* GT = (bf16_t*)(ws + WS_R2);
    bf16_t* P = (bf16_t*)(ws + WS_P);
    float* QK = (float*)(ws + WS_QK);
    float* stash = (float*)(ws + WS_O1) + (size_t)bx * 64 * 512;
    float* X = a.out;

    {
        const unsigned simd = (unsigned)__builtin_amdgcn_s_getreg(((2 - 1) << 11) | (4 << 6) | 4);
        volatile LAS unsigned* sw = (volatile LAS unsigned*)(lds + 131072 + 64);
        sw[wave] = simd;
        __syncthreads();
        unsigned rank = 0;
        for (int w = 0; w < 8; ++w) if (w < wave && sw[w] == simd) ++rank;
        __syncthreads();
        sw[8 + wave] = rank & 1u;
        __syncthreads();
    }
    { volatile LAS unsigned* st0 = (volatile LAS unsigned*)(lds + 131072 + 128); if (tid < 2) st0[tid] = 0u; }
    __syncthreads();
    const XcdBarrier gbar = xcd_barrier_post((unsigned*)(a.ws + WS_BAR), (volatile LAS unsigned*)(lds + 131072 + 128));
    {
        LAS float* scr = (LAS float*)(lds + wave * 16384);
        constexpr int I_IN = 16 * 176, I_OUT = 44 * 32, I_WB = 8 * 32, I_WO = 16 * 32, I_LAYER = 3 * I_IN + 2 * I_OUT + 3 * I_WB + I_WO;
        for (int it = gw; it < 2 * I_LAYER; it += NGW) {
            const int l = it / I_LAYER; int r = it - l * I_LAYER;
            unsigned char* wl = ws + WS_W + (size_t)l * W_LAYER;
            if (r < I_IN || (r >= I_IN + I_OUT + I_IN + 3 * I_WB + I_WO && r < I_IN + I_OUT + I_IN + 3 * I_WB + I_WO + I_IN)) {
                const bool second = r >= I_IN; if (second) r -= I_IN + I_OUT + I_IN + 3 * I_WB + I_WO;
                const int kb = r / 176, nb = r % 176, n0 = 32 * nb, pn = n0 >> 8, bj = (n0 >> 7) & 1, j0 = n0 & 127;
                tr_item(a.in[second ? 18 : 3] + (size_t)l * 1024 * 5632, 5632, 64 * kb, bj * 2816 + 128 * pn + j0, (bf16_t*)(wl + (second ? W_2IN : W_1IN)), 1024, n0, 1, 0, a.in[second ? 17 : 2] + l * 1024, scr, lane);
                continue;
            }
            r -= I_IN;
            if (r < I_OUT) { const int kb = r / 32, nb = r % 32; tr_item(a.in[4] + (size_t)l * 2816 * 1024, 1024, 64 * kb, 32 * nb, (bf16_t*)(wl + W_1OUT), 2816, 32 * nb, 1, 0, nullptr, scr, lane); continue; }
            r -= I_OUT;
            if (r < I_IN) { const int kb = r / 176, nb = r % 176; tr_item(a.in[6] + (size_t)l * 1024 * 5632, 5632, 64 * kb, 32 * nb, (bf16_t*)(wl + W_IN), 1024, 32 * nb, 1, 0, a.in[5] + l * 1024, scr, lane); continue; }
            r -= I_IN;
            if (r < 3 * I_WB) { const int br = r / I_WB; r -= br * I_WB; const int kb = r / 32, nb = r % 32;
                tr_item(a.in[15] + (size_t)(l * 3 + br) * 512 * 1024, 1024, 64 * kb, 32 * nb, (bf16_t*)(wl + W_B), 512, br * 1024 + 32 * nb, 1, 0, nullptr, scr, lane); continue; }
            r -= 3 * I_WB;
            if (r < I_WO) { const int kb = r / 32, nb = r % 32; tr_item(a.in[16] + (size_t)l * 1024 * 1024, 1024, 64 * kb, 32 * nb, (bf16_t*)(wl + W_O3), 3072, 32 * nb, 3, 1024, nullptr, scr, lane); continue; }
            r -= I_WO + I_IN;
            { const int kb = r / 32, nb = r % 32; tr_item(a.in[19] + (size_t)l * 2816 * 1024, 1024, 64 * kb, 32 * nb, (bf16_t*)(wl + W_2OUT), 2816, 32 * nb, 1, 0, nullptr, scr, lane); }
        }
        for (int row = gw; row < T; row += NGW) {
            const f32x4* xr = (const f32x4*)(a.in[0] + (size_t)row * D) + lane; float s = 0.f;
            unsigned long long* o8 = (unsigned long long*)(XB + (size_t)row * D) + lane;
#pragma unroll
            for (int j = 0; j < 4; ++j) { const f32x4 v = xr[64 * j]; s += (v.x * v.x + v.y * v.y) + (v.z * v.z + v.w * v.w);
                o8[64 * j] = (unsigned long long)pk2(v.x, v.y) | ((unsigned long long)pk2(v.z, v.w) << 32); }
            s = wave_sum(s);
            if (lane == 0) ssb[row] = s;
        }
        for (int i = bx * 512 + tid; i < 6 * T; i += G * 512) ssb[T + i] = 0.f;
        if (bx == 0) {
            for (int i = tid; i < 12 * 257; i += 512) { const int hh = i / 257, rel = i % 257 - 128; lutg[i] = a.in[1][t5_bucket(rel) * 12 + hh] * LOG2E; }
            if (wave < 2) { const int l = wave;
                const float s1 = wave_sum(a.in[10][l * 64 + lane] * a.in[11][l * 64 + lane]), s2 = wave_sum(a.in[12][l * 64 + lane] * a.in[13][l * 64 + lane]);
                const float li = 0.8f - 0.6f * expf(-0.3f * (float)l);
                if (lane == 0) lamb[l] = expf(s1) - expf(s2) + li; }
        }
    }
    xcd_barrier(gbar);
    if (gridDim.x == 0x7fffffffu) grid.sync();

    for (int l = 0; l < 2; ++l) {
        unsigned char* wl = ws + WS_W + (size_t)l * W_LAYER;
        const float lambda_init = 0.8f - 0.6f * expf(-0.3f * (float)l);
        for (int f = 0; f < 2; ++f) {
            {
                pg8::Gemm g{XB, (const bf16_t*)(wl + (f ? W_2IN : W_1IN)), T, NIN, D, D, D, 1 << 20, 0};
                pg8::StaticOrder S; S.init(T, NIN, G, bx);
                pg8::EpiSwiGLU E{ACT, ssb + (size_t)(3 * l + 2 * f) * T, DFF};
                pg8::gemm_phase<pg8::EpiSwiGLU, pg8::StaticOrder, true, true>(lds, g, S, E);
            }
            xcd_barrier(gbar);
            {
                pg8::Gemm g{ACT, (const bf16_t*)(wl + (f ? W_2OUT : W_1OUT)), T, D, DFF, DFF, DFF, 1 << 20, 0};
                pg8::StaticOrder S; S.init(T, D, G, bx);
                pg8::EpiResid E{(l == 0 && f == 0) ? a.in[0] : (const float*)X, X, (l == 1 && f == 1) ? (bf16_t*)nullptr : XB, ssb + (size_t)(3 * l + 2 * f + 1) * T, 0.5f};
                pg8::gemm_phase<pg8::EpiResid, pg8::StaticOrder, true, true>(lds, g, S, E);
            }
            xcd_barrier(gbar);
            if (f == 1) break;
            for (int b = 0; b < NBATCH; ++b) {
                const size_t rb = (size_t)b * SEQ;
                {
                    pg8::Gemm g{XB + rb * D, (const bf16_t*)(wl + W_IN), SEQ, NIN, D, D, D, 1 << 20, 0};
                    pg8::StaticOrder S; S.init(SEQ, NIN, G, bx);
                    pg8::EpiProj E{P, QK, GT, ssb + (size_t)(3 * l + 1) * T + rb};
                    pg8::gemm_phase<pg8::EpiProj, pg8::StaticOrder, true, true>(lds, g, S, E);
                }
                xcd_barrier(gbar);
                {
                    const int lane = opaque_tid() & 63; const int p = lane & 31, half = p >> 4, i = p & 15, hd = lane >> 5;
                    const float freq = __builtin_amdgcn_exp2f(-(float)i * (13.287712379549449f / 16.0f));
                    const float gk1 = a.in[8][l * 64 + half * 32 + i], gk2 = a.in[8][l * 64 + half * 32 + 16 + i];
                    LAS bf16_t* stg = (LAS bf16_t*)(lds + wave * 8192);
                    for (int t0 = gw; t0 < SEQ; t0 += NGW * 4) {
                        float x1[4], x2[4];
#pragma unroll
                        for (int k = 0; k < 4; ++k) { const float* src = QK + (size_t)(t0 + k * NGW) * QKW + 512 + hd * 64 + half * 32 + i; x1[k] = src[0]; x2[k] = src[16]; }
#pragma unroll
                        for (int k = 0; k < 4; ++k) { const int tl = t0 + k * NGW;
                            const float pos = (float)(half ? (tl & 63) : (tl >> 6));
                            float rev = pos * freq * 0.15915494309189535f; rev -= floorf(rev);
                            const float sn = __builtin_amdgcn_sinf(rev), cs = __builtin_amdgcn_cosf(rev);
                            float a1 = x1[k], a2 = x2[k]; float s = a1 * a1 + a2 * a2;
#pragma unroll
                            for (int o = 1; o < 32; o <<= 1) s += __shfl_xor(s, o);
                            const float r = __builtin_amdgcn_rsqf(s * (1.0f / 64.0f) + EPS);
                            a1 *= r * gk1; a2 *= r * gk2;
                            stg[k * 128 + hd * 64 + half * 32 + i] = (bf16_t)f2bf(a1 * cs - a2 * sn); stg[k * 128 + hd * 64 + half * 32 + i + 16] = (bf16_t)f2bf(a1 * sn + a2 * cs); }
                        LDS_WAIT();
#pragma unroll
                        for (int k = 0; k < 4; ++k) if (lane < 16) *(v4u*)(P + (size_t)(t0 + k * NGW) * PW + 512 + lane * 8) = *(const LAS v4u*)(stg + k * 128 + lane * 8);
                        LDS_WAIT();
                    }
                }
                xcd_barrier(gbar);
                {
                    const float lam = lamb[l];
                    for (int uc = vcu; uc < 256; uc += G) att::unit_c(lds, P, uc >> 6, uc & 63, lutg, lam, 1.0f - lambda_init, a.in[14] + l * 128, stash);

                    bool bounded; { float gq = 0.f, gk = 0.f; for (int e = 0; e < 64; ++e) { gq = fmaxf(gq, fabsf(a.in[7][l * 64 + e])); gk = fmaxf(gk, fabsf(a.in[8][l * 64 + e])); } bounded = (8.0f * gq * gk * LOG2E < 24.0f); }
                    for (int ua = vcu; ua < 512; ua += G) att::unit_a(lds, P, QK, a.in[7] + l * 64, ua >> 6, ua & 63, bounded);

                    for (int ub = vcu; ub < 512; ub += G) att::unit_b(lds, P, ub >> 6, ub & 63, lutg, a.in[9][l * 8 + (ub >> 6)] * LOG2E);
                }
                xcd_barrier(gbar);
                {
                    pg8::Gemm g{P, (const bf16_t*)(wl + W_B), SEQ, GW, 512, PW, 512, 4, 768};
                    pg8::BranchOrder S{G, bx};
                    pg8::EpiGateSum E{GT, (bf16_t*)(ws + WS_QK)};
                    pg8::gemm_phase<pg8::EpiGateSum, pg8::BranchOrder, true, true>(lds, g, S, E);
                }
                xcd_barrier(gbar);
                {
                    pg8::Gemm g{(const bf16_t*)(ws + WS_QK), (const bf16_t*)(wl + W_O3), SEQ, D, D, D, GW, 1 << 20, 0};
                    pg8::StaticOrder S; S.init(SEQ, D, G, bx);
                    pg8::EpiResid E{X + rb * D, X + rb * D, XB + rb * D, ssb + (size_t)(3 * l + 2) * T + rb, 1.0f};
                    pg8::gemm_phase<pg8::EpiResid, pg8::StaticOrder, true, true>(lds, g, S, E);
                }
                xcd_barrier(gbar);
            }
        }
    }
    const int lane_f = opaque_tid() & 63;
    for (int row = gw; row < T; row += NGW) {
        const int lane = lane_f;
        const float rs = __builtin_amdgcn_rsqf(ssb[(size_t)6 * T + row] * (1.0f / 1024.0f) + EPS);
        f32x4* xr = (f32x4*)(X + (size_t)row * D) + lane; const f32x4* gr = (const f32x4*)a.in[20] + lane;
#pragma unroll
        for (int j = 0; j < 4; ++j) { const f32x4 v = xr[64 * j], g = gr[64 * j]; f32x4 ov = v * rs * g;
            xr[64 * j] = ov; }
    }
}

extern "C" void kernel_launch(void* const* d_in, const int* in_sizes, int n_in, void* d_out, int out_size, void* d_ws, size_t ws_size, hipStream_t stream) {
    static int grid = 0;
    if (grid == 0) {
        if (n_in != 21 || out_size != T * D || ws_size < WS_END) { fprintf(stderr, "kernel_launch: unexpected shapes (n_in %d out %d ws %zu)\n", n_in, out_size, ws_size); grid = -1; return; }
        int dev = 0, cus = 0;
        if (hipGetDevice(&dev) != hipSuccess || hipDeviceGetAttribute(&cus, hipDeviceAttributeMultiprocessorCount, dev) != hipSuccess) { grid = -1; return; }
        if (hipFuncSetAttribute((const void*)fwd_megakernel, hipFuncAttributeMaxDynamicSharedMemorySize, LDS_BYTES) != hipSuccess) { fprintf(stderr, "kernel_launch: hipFuncSetAttribute failed\n"); grid = -1; return; }
        int per_cu = 0;
        if (hipOccupancyMaxActiveBlocksPerMultiprocessor(&per_cu, (const void*)fwd_megakernel, 512, LDS_BYTES) != hipSuccess || per_cu < 1) fprintf(stderr, "kernel_launch: occupancy query says %d\n", per_cu);
        (void)hipGetLastError();
        grid = cus;
    }
    if (grid < 0) return;
    if (hipMemsetAsync((char*)d_ws + WS_BAR, 0, WS_BAR_BYTES, stream) != hipSuccess) { fprintf(stderr, "kernel_launch: hipMemsetAsync failed\n"); return; }
    Args a{};
    for (int i = 0; i < 21; ++i) a.in[i] = (const float*)d_in[i];
    a.out = (float*)d_out; a.ws = (unsigned char*)d_ws;
    void* args[] = {&a};
    hipError_t e = hipLaunchCooperativeKernel((const void*)fwd_megakernel, dim3(grid), dim3(512), args, LDS_BYTES, stream);
    if (e != hipSuccess) fprintf(stderr, "cooperative launch failed: %s (grid %d)\n", hipGetErrorString(e), grid);
}
```
